# Optimizing an MI355X kernel written in HIP

```python
import math
import jax, jax.numpy as jnp
from jax import lax
import numpy as np

D_MODEL = 1024
BATCH = 8
SEQ = 2048
DEPTH = 4
DEC_BATCH = 128
DEC_SEQ = 4
PAST_LEN = 16384
PAGE_SIZE = 128

N_MIXERS = 2
N_A = (DEPTH + 1) // 2
N_B = DEPTH // 2
H_A = 8
DV_A = D_MODEL // H_A
DK_A = DV_A // 2
QK_A = H_A * DK_A
VW_A = H_A * DV_A
A_IN = 2 * QK_A + 2 * VW_A + 2 * H_A
GATE_CAP = 15.0
HK_B = 8
HV_B = 16
DK_B = 128
DV_B = 128
QK_B = HK_B * DK_B
VW_B = HV_B * DV_B
CONV_W = 4
CONV_DIM = 2 * QK_B + VW_B
B_IN = CONV_DIM + VW_B + 2 * HV_B
CHUNK = 64
D_FF = 4 * D_MODEL
ALPHA = (2.0 * DEPTH) ** 0.25
BETA_INIT = (8.0 * DEPTH) ** -0.25
LN_EPS = 1e-5
RMS_EPS = 1e-6

kernel_name = "hybrid_mlstm_gdn_decode_step"


def layer_norm(x, g, b):
    xf = x.astype(jnp.float32)
    mu = xf.mean(-1, keepdims=True)
    var = jnp.square(xf - mu).mean(-1, keepdims=True)
    return ((xf - mu) * lax.rsqrt(var + LN_EPS) * g.astype(jnp.float32) + b.astype(jnp.float32)).astype(x.dtype)


def head_rms(h):
    return h * lax.rsqrt(jnp.mean(jnp.square(h), -1, keepdims=True) + RMS_EPS)


def l2norm(x):
    return x * lax.rsqrt(jnp.sum(jnp.square(x), -1, keepdims=True) + RMS_EPS)


def to_chunks(a, L):
    B, T = a.shape[:2]
    a = a.reshape((B, T // L, L) + a.shape[2:])
    return jnp.swapaxes(jnp.moveaxis(a, 1, 0), 2, 3)


def from_chunks(a):
    a = jnp.swapaxes(jnp.moveaxis(a, 0, 1), 2, 3)
    return a.reshape((a.shape[0], a.shape[1] * a.shape[2]) + a.shape[3:])


def mlstm_chunked(q, k, v, i_pre, logf, C0, n0, m0):
    T = q.shape[1]
    L = math.gcd(T, CHUNK)
    causal = jnp.tril(jnp.ones((L, L), dtype=bool))
    xs = (to_chunks(q, L), to_chunks(k, L), to_chunks(v, L), to_chunks(i_pre, L), to_chunks(logf, L))

    def step(carry, xc):
        C, n, m = carry
        qc, kc, vc, ic, fc = xc
        b = jnp.cumsum(fc, axis=-1)
        D = jnp.where(causal, b[..., :, None] - b[..., None, :] + ic[..., None, :], -jnp.inf)
        inter = b + m[..., None]
        m_t = jnp.maximum(inter, D.max(-1))
        w_intra = jnp.exp(D - m_t[..., None])
        w_inter = jnp.exp(inter - m_t)
        s = jnp.einsum('bhtk,bhsk->bhts', qc, kc) * w_intra
        num = jnp.einsum('bhts,bhsv->bhtv', s, vc) + w_inter[..., None] * jnp.einsum('bhtk,bhkv->bhtv', qc, C)
        den = s.sum(-1) + w_inter * jnp.einsum('bhtk,bhk->bht', qc, n)
        h = num / jnp.maximum(jnp.abs(den), jnp.exp(-m_t))[..., None]
        m_new = m_t[..., -1]
        w_k = jnp.exp(b[..., -1:] - b + ic - m_new[..., None])
        decay = jnp.exp(b[..., -1] + m - m_new)
        C_new = decay[..., None, None] * C + jnp.einsum('bhs,bhsk,bhsv->bhkv', w_k, kc, vc)
        n_new = decay[..., None] * n + jnp.einsum('bhs,bhsk->bhk', w_k, kc)
        return (C_new, n_new, m_new), h

    (C, n, m), h = lax.scan(step, (C0, n0, m0), xs)
    return from_chunks(h), C, n, m


def gated_delta_chunked(q, k, v, g, beta, S0):
    T = q.shape[1]
    L = math.gcd(T, CHUNK)
    qc, kc, vc, gc, bc = (to_chunks(a, L) for a in (q, k, v, g, beta))
    G = jnp.cumsum(gc, axis=-1)
    tril = jnp.tril(jnp.ones((L, L), dtype=bool))
    strict = jnp.tril(jnp.ones((L, L), dtype=bool), -1)
    decay = jnp.exp(jnp.where(tril, G[..., :, None] - G[..., None, :], -jnp.inf))
    kb = kc * bc[..., None]
    M = jnp.where(strict, jnp.einsum('...tk,...sk->...ts', kb, kc) * decay, 0.0)
    A = M + jnp.eye(L, dtype=M.dtype)
    rhs = jnp.concatenate([vc * bc[..., None], kb * jnp.exp(G)[..., None]], axis=-1)
    sol = lax.linalg.triangular_solve(A, rhs, left_side=True, lower=True)
    u, w = sol[..., :DV_B], sol[..., DV_B:]
    attn = jnp.einsum('...tk,...sk->...ts', qc, kc) * decay
    qg = qc * jnp.exp(G)[..., None]
    kdec = kc * jnp.exp(G[..., -1:] - G)[..., None]
    gL = jnp.exp(G[..., -1])

    def step(S, xc):
        u_c, w_c, attn_c, qg_c, kdec_c, gL_c = xc
        v_new = u_c - jnp.einsum('bhtk,bhkv->bhtv', w_c, S)
        o = jnp.einsum('bhtk,bhkv->bhtv', qg_c, S) + jnp.einsum('bhts,bhsv->bhtv', attn_c, v_new)
        S = gL_c[..., None, None] * S + jnp.einsum('bhsk,bhsv->bhkv', kdec_c, v_new)
        return S, o

    S, o = lax.scan(step, S0, (u, w, attn, qg, kdec, gL))
    return from_chunks(o), S


def mlstm_mixer(x, w_in, gate_b, norm_w, w_out, C0, n0, m0):
    B, T, _ = x.shape
    f32 = jnp.float32
    proj = x @ w_in
    q = proj[..., :QK_A].reshape(B, T, H_A, DK_A).astype(f32)
    k = proj[..., QK_A:2 * QK_A].reshape(B, T, H_A, DK_A).astype(f32) * (DK_A ** -0.5)
    v = proj[..., 2 * QK_A:2 * QK_A + VW_A].reshape(B, T, H_A, DV_A).astype(f32)
    o = proj[..., 2 * QK_A + VW_A:2 * QK_A + 2 * VW_A].astype(f32)
    gates = proj[..., 2 * QK_A + 2 * VW_A:].astype(f32) + gate_b.astype(f32)
    gates = GATE_CAP * jnp.tanh(gates / GATE_CAP)
    i_pre = gates[..., :H_A]
    logf = jax.nn.log_sigmoid(gates[..., H_A:])
    h, C, n, m = mlstm_chunked(q, k, v, i_pre, logf, C0.astype(f32), n0.astype(f32), m0.astype(f32))
    h = head_rms(h) * norm_w.astype(f32).reshape(H_A, DV_A)
    h = jax.nn.sigmoid(o) * h.reshape(B, T, VW_A)
    return h.astype(x.dtype) @ w_out, C, n, m


def gdn_mixer(x, w_in, conv_w, dt_bias, a_log, norm_w, w_out, S0, conv0):
    B, T, _ = x.shape
    f32 = jnp.float32
    proj = x @ w_in
    qkv = proj[..., :CONV_DIM]
    z = proj[..., CONV_DIM:CONV_DIM + VW_B].astype(f32)
    b = proj[..., CONV_DIM + VW_B:CONV_DIM + VW_B + HV_B].astype(f32)
    a = proj[..., CONV_DIM + VW_B + HV_B:].astype(f32)
    xp = jnp.concatenate([conv0.astype(qkv.dtype), qkv], axis=1)
    c = xp[:, 0:T] * conv_w[0]
    for j in range(1, CONV_W):
        c = c + xp[:, j:j + T] * conv_w[j]
    c = jax.nn.silu(c.astype(f32))
    new_conv = xp[:, T:]
    rep = HV_B // HK_B
    q = l2norm(c[..., :QK_B].reshape(B, T, HK_B, DK_B)) * (DK_B ** -0.5)
    k = l2norm(c[..., QK_B:2 * QK_B].reshape(B, T, HK_B, DK_B))
    v = c[..., 2 * QK_B:].reshape(B, T, HV_B, DV_B)
    q = jnp.repeat(q, rep, axis=2)
    k = jnp.repeat(k, rep, axis=2)
    beta = jax.nn.sigmoid(b)
    g = -jnp.exp(a_log.astype(f32)) * jax.nn.softplus(a + dt_bias.astype(f32))
    o, S = gated_delta_chunked(q, k, v, g, beta, S0.astype(f32))
    o = head_rms(o) * norm_w.astype(f32).reshape(HV_B, DV_B)
    o = o.reshape(B, T, VW_B) * jax.nn.silu(z)
    return o.astype(x.dtype) @ w_out, S, new_conv


def sq_relu_mlp(x, w1, w2):
    return jnp.square(jax.nn.relu(x @ w1)) @ w2


def trunk(x, C, n, m, S, conv, a_w_in, a_gate_b, a_norm_w, a_w_out, b_w_in, b_conv_w, b_dt_bias,
          b_a_log, b_norm_w, b_w_out, mlp_w1, mlp_w2, ln1_g, ln1_b, ln2_g, ln2_b):
    new_C, new_n, new_m, new_S, new_conv = [], [], [], [], []
    for layer in range(DEPTH):
        j = layer // N_MIXERS
        if layer % N_MIXERS == 0:
            y, Cj, nj, mj = mlstm_mixer(x, a_w_in[j], a_gate_b[j], a_norm_w[j], a_w_out[j], C[j], n[j], m[j])
            new_C.append(Cj.astype(C.dtype)); new_n.append(nj.astype(n.dtype)); new_m.append(mj.astype(m.dtype))
        else:
            y, Sj, cj = gdn_mixer(x, b_w_in[j], b_conv_w[j], b_dt_bias[j], b_a_log[j], b_norm_w[j], b_w_out[j],
                                  S[j], conv[j])
            new_S.append(Sj.astype(S.dtype)); new_conv.append(cj.astype(conv.dtype))
        x = layer_norm(ALPHA * x + y, ln1_g[layer], ln1_b[layer])
        x = layer_norm(ALPHA * x + sq_relu_mlp(x, mlp_w1[layer], mlp_w2[layer]), ln2_g[layer], ln2_b[layer])
    return x, jnp.stack(new_C), jnp.stack(new_n), jnp.stack(new_m), jnp.stack(new_S), jnp.stack(new_conv)


def setup_inputs(seed: int = 0) -> dict:
    key = jax.random.key(seed)
    ks = jax.random.split(key, 24)
    nrm = jax.random.normal
    f32 = jnp.float32
    x_prompt = nrm(ks[0], (BATCH, SEQ, D_MODEL), f32)
    x_sample = nrm(ks[1], (DEC_BATCH, DEC_SEQ, D_MODEL), f32)
    state_mlstm_C = nrm(ks[2], (N_A, DEC_BATCH, H_A, DK_A, DV_A), f32)
    state_mlstm_n = nrm(ks[3], (N_A, DEC_BATCH, H_A, DK_A), f32)
    state_mlstm_m = nrm(ks[4], (N_A, DEC_BATCH, H_A), f32)
    state_gdn_S = nrm(ks[5], (N_B, DEC_BATCH, HV_B, DK_B, DV_B), f32)
    state_gdn_conv = nrm(ks[6], (N_B, DEC_BATCH, CONV_W - 1, CONV_DIM), f32)
    a_scale = jnp.concatenate([jnp.ones((2 * QK_A,), f32), jnp.full((VW_A,), BETA_INIT, f32),
                               jnp.ones((VW_A + 2 * H_A,), f32)])
    a_w_in = nrm(ks[7], (N_A, D_MODEL, A_IN), f32) * (D_MODEL ** -0.5) * a_scale
    i_bias = 0.1 * nrm(ks[8], (N_A, H_A), f32)
    f_bias = jnp.linspace(3.0, 6.0, H_A, dtype=f32)[None, :] + 0.1 * nrm(ks[9], (N_A, H_A), f32)
    a_gate_b = jnp.concatenate([i_bias, f_bias], axis=-1)
    a_norm_w = 1.0 + 0.05 * nrm(ks[10], (N_A, VW_A), f32)
    a_w_out = nrm(ks[11], (N_A, VW_A, D_MODEL), f32) * (VW_A ** -0.5) * BETA_INIT
    b_scale = jnp.concatenate([jnp.ones((2 * QK_B,), f32), jnp.full((VW_B,), BETA_INIT, f32),
                               jnp.ones((VW_B + 2 * HV_B,), f32)])
    b_w_in = nrm(ks[12], (N_B, D_MODEL, B_IN), f32) * (D_MODEL ** -0.5) * b_scale
    b_conv_w = nrm(ks[13], (N_B, CONV_W, CONV_DIM), f32) * (CONV_W ** -0.5)
    dt = jnp.exp(jax.random.uniform(ks[14], (N_B, HV_B), f32, math.log(1e-3), math.log(1e-1)))
    b_dt_bias = dt + jnp.log(-jnp.expm1(-dt))
    b_a_log = jnp.log(jax.random.uniform(ks[15], (N_B, HV_B), f32, 1.0, 16.0))
    b_norm_w = 1.0 + 0.05 * nrm(ks[16], (N_B, VW_B), f32)
    b_w_out = nrm(ks[17], (N_B, VW_B, D_MODEL), f32) * (VW_B ** -0.5) * BETA_INIT
    mlp_w1 = nrm(ks[18], (DEPTH, D_MODEL, D_FF), f32) * (D_MODEL ** -0.5) * BETA_INIT
    mlp_w2 = nrm(ks[19], (DEPTH, D_FF, D_MODEL), f32) * (D_FF ** -0.5) * BETA_INIT
    ln1_g = 1.0 + 0.05 * nrm(ks[20], (DEPTH, D_MODEL), f32)
    ln1_b = 0.02 * nrm(ks[21], (DEPTH, D_MODEL), f32)
    ln2_g = 1.0 + 0.05 * nrm(ks[22], (DEPTH, D_MODEL), f32)
    ln2_b = 0.02 * nrm(ks[23], (DEPTH, D_MODEL), f32)
    return {"x_prompt": x_prompt, "x_sample": x_sample,
            "state_mlstm_C": state_mlstm_C, "state_mlstm_n": state_mlstm_n, "state_mlstm_m": state_mlstm_m,
            "state_gdn_S": state_gdn_S, "state_gdn_conv": state_gdn_conv,
            "a_w_in": a_w_in, "a_gate_b": a_gate_b, "a_norm_w": a_norm_w, "a_w_out": a_w_out,
            "b_w_in": b_w_in, "b_conv_w": b_conv_w, "b_dt_bias": b_dt_bias, "b_a_log": b_a_log,
            "b_norm_w": b_norm_w, "b_w_out": b_w_out,
            "mlp_w1": mlp_w1, "mlp_w2": mlp_w2,
            "ln1_g": ln1_g, "ln1_b": ln1_b, "ln2_g": ln2_g, "ln2_b": ln2_b}


def reference(x_prompt, x_sample, state_mlstm_C, state_mlstm_n, state_mlstm_m, state_gdn_S, state_gdn_conv,
              a_w_in, a_gate_b, a_norm_w, a_w_out, b_w_in, b_conv_w, b_dt_bias, b_a_log, b_norm_w, b_w_out,
              mlp_w1, mlp_w2, ln1_g, ln1_b, ln2_g, ln2_b):
    weights = (a_w_in, a_gate_b, a_norm_w, a_w_out, b_w_in, b_conv_w, b_dt_bias, b_a_log, b_norm_w, b_w_out,
               mlp_w1, mlp_w2, ln1_g, ln1_b, ln2_g, ln2_b)
    Bp = x_prompt.shape[0]
    dt = x_prompt.dtype
    C0 = jnp.zeros((N_A, Bp, H_A, DK_A, DV_A), dt)
    n0 = jnp.zeros((N_A, Bp, H_A, DK_A), dt)
    m0 = jnp.zeros((N_A, Bp, H_A), dt)
    S0 = jnp.zeros((N_B, Bp, HV_B, DK_B, DV_B), dt)
    conv0 = jnp.zeros((N_B, Bp, CONV_W - 1, CONV_DIM), dt)
    y_prompt, p_C, p_n, p_m, p_S, p_conv = trunk(x_prompt, C0, n0, m0, S0, conv0, *weights)
    y_sample, s_C, s_n, s_m, s_S, s_conv = trunk(x_sample, state_mlstm_C, state_mlstm_n, state_mlstm_m,
                                                 state_gdn_S, state_gdn_conv, *weights)
    return (y_prompt, y_sample, p_C, p_n, p_m, p_S, p_conv, s_C, s_n, s_m, s_S, s_conv)
```

```cpp
#include <hip/hip_runtime.h>
#include <hip/hip_cooperative_groups.h>
#include <cstdio>
#include <cstdint>
namespace cg = cooperative_groups;

#define LAS __attribute__((address_space(3)))
typedef unsigned short bf16_t;
typedef short bf16x8 __attribute__((ext_vector_type(8)));
typedef float f32x4 __attribute__((ext_vector_type(4)));
typedef unsigned u32x4 __attribute__((ext_vector_type(4)));
typedef unsigned u32x2 __attribute__((ext_vector_type(2)));

constexpr int D_MODEL = 1024, MP = 16384, MS = 512, MT = MP + MS;
constexpr int SEQ = 2048, DEC_SEQ = 4, BATCH = 8, DEC_BATCH = 128;
constexpr int A_IN = 3088, A_INP = 3328, B_IN = 6176, B_INP = 6400, D_FF = 4096;
constexpr float ALPHA = 1.681792830507429f;
constexpr int NTHR = 512;
constexpr int LDS_BYTES = 161792;

constexpr size_t SZ_AIN = (size_t)A_INP * 1024 * 2, SZ_AOUT = (size_t)1024 * 1024 * 2, SZ_BIN = (size_t)B_INP * 1024 * 2,
                 SZ_BOUT = (size_t)1024 * 2048 * 2, SZ_W1 = (size_t)4096 * 1024 * 2, SZ_W2 = (size_t)1024 * 4096 * 2;
constexpr size_t WS_AIN = 0, WS_AOUT = WS_AIN + 2 * SZ_AIN, WS_BIN = WS_AOUT + 2 * SZ_AOUT, WS_BOUT = WS_BIN + 2 * SZ_BIN,
                 WS_W1 = WS_BOUT + 2 * SZ_BOUT, WS_W2 = WS_W1 + 4 * SZ_W1, WS_XF = WS_W2 + 4 * SZ_W2,
                 WS_XB = WS_XF + (size_t)MT * 1024 * 4, WS_T = WS_XB + (size_t)MT * 1024 * 2, WS_PROJ = WS_T + (size_t)MT * 1024 * 4,
                 WS_H = WS_PROJ + (size_t)MT * B_INP * 2, WS_HID = WS_H + (size_t)MT * 2048 * 2, WS_GATES = WS_HID + (size_t)MT * 4096 * 2,
                 WS_BAR = WS_GATES + (size_t)MT * 32 * 4, WS_END = WS_BAR + 16384;

constexpr size_t O_YP = 0, O_YS = O_YP + (size_t)MP * 1024, O_PC = O_YS + (size_t)MS * 1024, O_PN = O_PC + (size_t)2 * 8 * 8 * 64 * 128,
                 O_PM = O_PN + 2 * 8 * 8 * 64, O_PS = O_PM + 2 * 8 * 8, O_PCONV = O_PS + (size_t)2 * 8 * 16 * 128 * 128,
                 O_SC = O_PCONV + (size_t)2 * 8 * 3 * 4096, O_SN = O_SC + (size_t)2 * 128 * 8 * 64 * 128, O_SM = O_SN + (size_t)2 * 128 * 8 * 64,
                 O_SS = O_SM + 2 * 128 * 8, O_SCONV = O_SS + (size_t)2 * 128 * 16 * 128 * 128, O_END = O_SCONV + (size_t)2 * 128 * 3 * 4096;

struct Params { const float* in[23]; float* out; unsigned char* ws; };

__device__ __forceinline__ float bf2f(bf16_t b) { return __uint_as_float(((unsigned)b) << 16); }

typedef float f32x2 __attribute__((ext_vector_type(2)));
typedef __bf16 bf16x2_t __attribute__((ext_vector_type(2)));
__device__ __forceinline__ unsigned cvt_pk_bf16(float lo, float hi) { f32x2 v = {lo, hi}; bf16x2_t b = __builtin_convertvector(v, bf16x2_t); return __builtin_bit_cast(unsigned, b); }
__device__ __forceinline__ bf16_t f2bf(float f) { return (bf16_t)cvt_pk_bf16(f, 0.f); }
__device__ __forceinline__ float sigmoidf_(float x) { return __builtin_amdgcn_rcpf(1.0f + __expf(-x)); }
__device__ __forceinline__ float tanh15_(float g) { return 15.0f - 30.0f * __builtin_amdgcn_rcpf(1.0f + __expf(g * (2.0f / 15.0f))); }
__device__ __forceinline__ float logsig_(float x) { return -__logf(1.0f + __expf(-x)); }
__device__ __forceinline__ float softplus_(float x) { return x > 20.f ? x : __logf(1.0f + __expf(x)); }
template <int CTRL> __device__ __forceinline__ float dpp_perm(float v) {
    return __builtin_bit_cast(float, __builtin_amdgcn_update_dpp(0, __builtin_bit_cast(int, v), CTRL, 0xF, 0xF, true));
}
__device__ __forceinline__ float row16_sum(float v) { v += dpp_perm<0x128>(v); v += dpp_perm<0x124>(v); v += dpp_perm<0x122>(v); v += dpp_perm<0x121>(v); return v; }
__device__ __forceinline__ float oct_sum(float v) { v += dpp_perm<0xB1>(v); v += dpp_perm<0x4E>(v); v += dpp_perm<0x141>(v); return v; }
__device__ __forceinline__ float wave_sum(float v) { v = row16_sum(v); v += __shfl_xor(v, 16, 64); v += __shfl_xor(v, 32, 64); return v; }

namespace pg8 {
constexpr int BM = 256, BK = 64, HALF = 128, HTB = HALF * BK * 2, STAGE_BYTES = 8 * HTB, NXCD = 8, WGM = 8;
__host__ __device__ __forceinline__ int lds_byte(int r, int c) { const int st = (r >> 4) * 2 + (c >> 5), rr = r & 15, cc = c & 31, ob = rr * 64 + cc * 2; return st * 1024 + (ob ^ (((ob >> 9) & 1) << 5)); }
__host__ __device__ __forceinline__ void stage_rc(int b, int& R, int& C) { const int st = b / 1024, sb = b % 1024, swz = sb ^ (((sb >> 9) & 1) << 5); R = (st >> 1) * 16 + swz / 64; C = (st & 1) * 32 + (swz % 64) / 2; }
__host__ __device__ __forceinline__ int perm32(int rho) { const int n = rho >> 4, i = rho & 15; return 8 * (i >> 2) + 4 * n + (i & 3); }
struct Unit { int pm, pn; };
struct Gemm { const bf16_t* A; const bf16_t* Bt; int M, N, K; };
struct StaticOrder {
    int nM, nN, nwg, G, c;
    __device__ void init(int M, int N, int G_, int c_) { nM = M / BM; nN = N / BM; nwg = nM * nN; G = G_; c = c_; }
    __device__ bool next(int i, Unit& u) const {
        const long L = (long)i * G + c; if (L >= nwg) return false;
        int wgid = (int)L; { const int q = nwg / NXCD, r = nwg % NXCD, xcd = wgid % NXCD, off = wgid / NXCD; wgid = (xcd < r ? xcd * (q + 1) : r * (q + 1) + (xcd - r) * q) + off; }
        const int nig = WGM * nN, gid = wgid / nig, fm = gid * WGM, gsz = (nM - fm) < WGM ? (nM - fm) : WGM;
        u.pm = fm + ((wgid % nig) % gsz); u.pn = (wgid % nig) / gsz; return true;
    }
};

struct Epi { int mode; bf16_t* O; int ldc; float* gates; int gate_pn, ngate; bf16_t* T; const bf16_t* X; int act_lo, act_hi, act_kind; };
__device__ __forceinline__ void epi_run(const Epi& E, const f32x4 (&acc)[2][2][4][2], const Unit& u, int wr, int wc, int fr, int fq);
__device__ __forceinline__ void gemm_phase(LAS unsigned char* lds, const Gemm g, const StaticOrder& S, const Epi& E, const int tid) {
    const int wid = __builtin_amdgcn_readfirstlane(tid >> 6), lane = tid & 63, wr = wid >> 2, wc = wid & 3, fr = lane & 15, fq = lane >> 4;
    const int K = g.K, nt = K / BK;
    unsigned voffA[2], voffB[2];
#pragma unroll
    for (int i = 0; i < 2; ++i) { int R, C; stage_rc(tid * 16 + i * 8192, R, C); const int Rb = (R & ~31) + perm32(R & 31);
        voffA[i] = (unsigned)(R * K + C) * 2u; voffB[i] = (unsigned)(Rb * K + C) * 2u; }
    const size_t kstep = (size_t)(BK * 2);
    const size_t hstep = (size_t)HALF * K * 2;
    const size_t tstep = 2 * hstep;
    const unsigned ldsw = (unsigned)wid * 1024u;
    const int aoff = lds_byte(wr * 64 + fr, fq * 8), boff = lds_byte(wc * 32 + fr, fq * 8);
#define PG8_SA(b, h) (((b) * 2 + (h)) * HTB)
#define PG8_SB(b, h) ((4 + (b) * 2 + (h)) * HTB)
#define PG8_STAGE(bufoff, gbase, voff) do { _Pragma("unroll") for (int _i = 0; _i < 2; ++_i) \
        __builtin_amdgcn_global_load_lds((const unsigned*)((const char*)(gbase) + (voff)[_i]), (LAS unsigned*)(lds + (bufoff) + ldsw + _i * 8192), 16, 0, 0); } while (0)
#define PG8_LDA(dst, b, h) do { _Pragma("unroll") for (int m = 0; m < 4; ++m) _Pragma("unroll") for (int k = 0; k < 2; ++k) dst[m][k] = *(const LAS bf16x8*)(lds + PG8_SA(b, h) + aoff + m * 2048 + k * 1024); } while (0)
#define PG8_LDB(dst, b, h) do { _Pragma("unroll") for (int n = 0; n < 2; ++n) _Pragma("unroll") for (int k = 0; k < 2; ++k) dst[n][k] = *(const LAS bf16x8*)(lds + PG8_SB(b, h) + boff + n * 2048 + k * 1024); } while (0)
#define PG8_MMA(ai, bj, At, Bt) do { __builtin_amdgcn_s_setprio(1); _Pragma("unroll") for (int m = 0; m < 4; ++m) _Pragma("unroll") for (int n = 0; n < 2; ++n) _Pragma("unroll") for (int k = 0; k < 2; ++k) \
        acc[ai][bj][m][n] = __builtin_amdgcn_mfma_f32_16x16x32_bf16(Bt[n][k], At[m][k], acc[ai][bj][m][n], 0, 0, 0); __builtin_amdgcn_s_setprio(0); } while (0)
#define PG8_WAIT_V(n) asm volatile("s_waitcnt vmcnt(" #n ")" ::: "memory")
#define PG8_WAIT_L(n) asm volatile("s_waitcnt lgkmcnt(" #n ")" ::: "memory")
#define PG8_BAR __builtin_amdgcn_s_barrier()
#define PG8_SCHED __builtin_amdgcn_sched_barrier(0)
    Unit cur, nxt; int ui = 0;
    if (!S.next(0, cur)) return;
    f32x4 acc[2][2][4][2];
#pragma unroll
    for (int a = 0; a < 2; ++a)
#pragma unroll
        for (int b = 0; b < 2; ++b)
#pragma unroll
            for (int m = 0; m < 4; ++m)
#pragma unroll
                for (int n = 0; n < 2; ++n) acc[a][b][m][n] = (f32x4){0.f, 0.f, 0.f, 0.f};
    bf16x8 At[4][2], B0[2][2], B1[2][2];
    const char* cA = (const char*)g.A + (size_t)cur.pm * tstep; const char* cB = (const char*)g.Bt + (size_t)cur.pn * tstep;
    PG8_STAGE(PG8_SB(0, 0), cB, voffB); PG8_STAGE(PG8_SB(0, 1), cB + hstep, voffB); PG8_STAGE(PG8_SA(0, 0), cA, voffA); PG8_STAGE(PG8_SA(0, 1), cA + hstep, voffA);
    if (wr == 1) PG8_BAR;
    PG8_WAIT_V(2); PG8_BAR;
    PG8_STAGE(PG8_SB(1, 0), cB + kstep, voffB); PG8_STAGE(PG8_SA(1, 0), cA + kstep, voffA); PG8_STAGE(PG8_SB(1, 1), cB + hstep + kstep, voffB);
    PG8_WAIT_V(6); PG8_BAR;
    for (;;) {
        const bool has_next = S.next(ui + 1, nxt);
        const char* nA = has_next ? (const char*)g.A + (size_t)nxt.pm * tstep : cA; const char* nB = has_next ? (const char*)g.Bt + (size_t)nxt.pn * tstep : cB;
        for (int t = 0; t < nt; t += 2) {
            const bool last = (t == nt - 2);
            const char* a1 = cA + (size_t)(t + 1) * kstep;
            const char* a2 = last ? nA : cA + (size_t)(t + 2) * kstep; const char* b2 = last ? nB : cB + (size_t)(t + 2) * kstep;
            const char* a3 = a2 + kstep; const char* b3 = b2 + kstep;
            PG8_LDB(B0, 0, 0); PG8_LDB(B1, 0, 1); PG8_SCHED; PG8_LDA(At, 0, 0); PG8_STAGE(PG8_SA(1, 1), a1 + hstep, voffA);
            PG8_WAIT_V(8); PG8_WAIT_L(0); PG8_BAR; PG8_MMA(0, 0, At, B0); PG8_MMA(0, 1, At, B1); PG8_BAR; PG8_SCHED;
            PG8_LDA(At, 0, 1); PG8_STAGE(PG8_SB(0, 0), b2, voffB); PG8_STAGE(PG8_SB(0, 1), b2 + hstep, voffB); PG8_STAGE(PG8_SA(0, 0), a2, voffA);
            PG8_WAIT_V(8); PG8_WAIT_L(0); PG8_BAR; PG8_MMA(1, 0, At, B0); PG8_MMA(1, 1, At, B1); PG8_BAR; PG8_SCHED;
            PG8_LDB(B0, 1, 0); PG8_LDB(B1, 1, 1); PG8_SCHED; PG8_LDA(At, 1, 0); PG8_STAGE(PG8_SA(0, 1), a2 + hstep, voffA);
            PG8_WAIT_V(8); PG8_WAIT_L(0); PG8_BAR; PG8_MMA(0, 0, At, B0); PG8_MMA(0, 1, At, B1); PG8_BAR; PG8_SCHED;
            PG8_LDA(At, 1, 1); PG8_STAGE(PG8_SB(1, 0), b3, voffB); PG8_STAGE(PG8_SB(1, 1), b3 + hstep, voffB); PG8_STAGE(PG8_SA(1, 0), a3, voffA);
            PG8_WAIT_V(8); PG8_WAIT_L(0); PG8_BAR; PG8_MMA(1, 0, At, B0); PG8_MMA(1, 1, At, B1); PG8_BAR; PG8_SCHED;
        }
        if (wr == 0) PG8_BAR;
        epi_run(E, acc, cur, wr, wc, fr, fq);
        if (!has_next) break;
#pragma unroll
        for (int a = 0; a < 2; ++a)
#pragma unroll
            for (int b = 0; b < 2; ++b)
#pragma unroll
                for (int m = 0; m < 4; ++m)
#pragma unroll
                    for (int n = 0; n < 2; ++n) acc[a][b][m][n] = (f32x4){0.f, 0.f, 0.f, 0.f};
        cur = nxt; cA = nA; cB = nB; ++ui;
        if (wr == 1) PG8_BAR;
    }
    PG8_WAIT_V(0);
    PG8_BAR;
#undef PG8_SA
#undef PG8_SB
#undef PG8_STAGE
#undef PG8_LDA
#undef PG8_LDB
#undef PG8_MMA
#undef PG8_WAIT_V
#undef PG8_WAIT_L
#undef PG8_BAR
#undef PG8_SCHED
}

__device__ __forceinline__ void epi_run(const Epi& E, const f32x4 (&acc)[2][2][4][2], const Unit& u, int wr, int wc, int fr, int fq) {
    if (E.mode != 2) {
        const int row0 = u.pm * BM + wr * 64 + fr, col0 = u.pn * BM + wc * 32 + 8 * fq;
        const bool dog = (u.pn == E.gate_pn) && (wc == 0) && (8 * fq < E.ngate);
        const bool act = E.mode == 1;
        const int gact = (E.mode == 0 && u.pn >= E.act_lo && u.pn < E.act_hi) ? E.act_kind : 0;
#pragma unroll
        for (int ai = 0; ai < 2; ++ai)
#pragma unroll
            for (int m = 0; m < 4; ++m) {
                const int row = row0 + ai * HALF + m * 16;
                bf16_t* rowp = E.O + (size_t)row * E.ldc + col0;
#pragma unroll
                for (int bj = 0; bj < 2; ++bj) {
                    f32x4 v0 = acc[ai][bj][m][0], v1 = acc[ai][bj][m][1];
                    if (act) {
#pragma unroll
                        for (int e = 0; e < 4; ++e) { float a = fmaxf(v0[e], 0.f), b = fmaxf(v1[e], 0.f); v0[e] = a * a; v1[e] = b * b; }
                    }
                    if (gact) {
#pragma unroll
                        for (int e = 0; e < 4; ++e) { const float s0 = sigmoidf_(v0[e]), s1 = sigmoidf_(v1[e]); v0[e] = gact == 1 ? s0 : v0[e] * s0; v1[e] = gact == 1 ? s1 : v1[e] * s1; }
                    }
                    u32x4 pk; pk[0] = cvt_pk_bf16(v0[0], v0[1]); pk[1] = cvt_pk_bf16(v0[2], v0[3]); pk[2] = cvt_pk_bf16(v1[0], v1[1]); pk[3] = cvt_pk_bf16(v1[2], v1[3]);
                    *(u32x4*)(rowp + bj * HALF) = pk;
                }
                if (dog) { float* gp = E.gates + (size_t)row * 32 + 8 * fq; *(f32x4*)gp = acc[ai][0][m][0]; *(f32x4*)(gp + 4) = acc[ai][0][m][1]; }
            }
    } else {
        const int row0 = u.pm * BM + wr * 64 + fr, col0 = u.pn * BM + wc * 32 + 8 * fq;
#pragma unroll
        for (int ai = 0; ai < 2; ++ai)
#pragma unroll
            for (int m = 0; m < 4; ++m) {
                const size_t ro = (size_t)(row0 + ai * HALF + m * 16) * 1024 + col0;
#pragma unroll
                for (int bj = 0; bj < 2; ++bj) {
                    const u32x4 xr = *(const u32x4*)(E.X + ro + bj * HALF);
                    f32x4 x0, x1;
                    x0[0] = __uint_as_float(xr[0] << 16); x0[1] = __uint_as_float(xr[0] & 0xFFFF0000u); x0[2] = __uint_as_float(xr[1] << 16); x0[3] = __uint_as_float(xr[1] & 0xFFFF0000u);
                    x1[0] = __uint_as_float(xr[2] << 16); x1[1] = __uint_as_float(xr[2] & 0xFFFF0000u); x1[2] = __uint_as_float(xr[3] << 16); x1[3] = __uint_as_float(xr[3] & 0xFFFF0000u);
                    const f32x4 v0 = x0 * ALPHA + acc[ai][bj][m][0], v1 = x1 * ALPHA + acc[ai][bj][m][1];
                    u32x4 pk; pk[0] = cvt_pk_bf16(v0[0], v0[1]); pk[1] = cvt_pk_bf16(v0[2], v0[3]); pk[2] = cvt_pk_bf16(v1[0], v1[1]); pk[3] = cvt_pk_bf16(v1[2], v1[3]);
                    *(u32x4*)(E.T + ro + bj * HALF) = pk;
                }
            }
    }
}
}

__device__ __forceinline__ int opq_s0(int x) { asm volatile("" : "+s"(x)); return x; }
__device__ __forceinline__ int opq_v0(int x) { asm volatile("" : "+v"(x)); return x; }
__device__ __forceinline__ void transpose_w(const float* __restrict__ W, int K, int N, int Npad, bf16_t* __restrict__ Wt, LAS float* sm, int bid, int nb) {
    const int nkt = K / 64, nnt = Npad / 64, ntile = nkt * nnt, tid = opq_v0(threadIdx.x);
    float r[8];
    int tile = bid;
    if (tile < ntile) {
        const int k0 = (tile % nkt) * 64, n0 = (tile / nkt) * 64;
#pragma unroll
        for (int i = 0; i < 8; ++i) { const int idx = tid + i * NTHR, kk = idx >> 6, nn = idx & 63; r[i] = (n0 + nn < N) ? W[(size_t)(k0 + kk) * N + n0 + nn] : 0.f; }
    }
    for (; tile < ntile; tile += nb) {
        const int k0 = (tile % nkt) * 64, n0 = (tile / nkt) * 64;
#pragma unroll
        for (int i = 0; i < 8; ++i) { const int idx = tid + i * NTHR, kk = idx >> 6, nn = idx & 63; sm[kk * 65 + nn] = r[i]; }
        __syncthreads();
        const int nt = tile + nb;
        if (nt < ntile) {
            const int k1 = (nt % nkt) * 64, n1 = (nt / nkt) * 64;
#pragma unroll
            for (int i = 0; i < 8; ++i) { const int idx = tid + i * NTHR, kk = idx >> 6, nn = idx & 63; r[i] = (n1 + nn < N) ? W[(size_t)(k1 + kk) * N + n1 + nn] : 0.f; }
        }
#pragma unroll
        for (int i = 0; i < 4; ++i) { const int idx = tid + i * NTHR, nn = idx >> 5, k2 = (idx & 31) * 2;
            *(unsigned*)(Wt + (size_t)(n0 + nn) * K + k0 + k2) = cvt_pk_bf16(sm[k2 * 65 + nn], sm[(k2 + 1) * 65 + nn]); }
        __syncthreads();
    }
}

__device__ __forceinline__ void ln_phase(const int tid, const bf16_t* __restrict__ T, const float* __restrict__ g, const float* __restrict__ b, float* __restrict__ XF, bf16_t* __restrict__ XB) {
    const int lane = tid & 63, wv = blockIdx.x * 8 + (tid >> 6), nw = gridDim.x * 8;
    f32x4 gv[4], bv[4];
#pragma unroll
    for (int i = 0; i < 4; ++i) { const int c = (i >> 1) * 512 + lane * 8 + (i & 1) * 4; gv[i] = *(const f32x4*)(g + c); bv[i] = *(const f32x4*)(b + c); }
    for (int row = wv; row < MT; row += nw) {
        f32x4 x[4]; float s = 0.f;
#pragma unroll
        for (int h = 0; h < 2; ++h) {
            const u32x4 r = *(const u32x4*)(T + (size_t)row * 1024 + h * 512 + lane * 8);
            x[2 * h][0] = __uint_as_float(r[0] << 16); x[2 * h][1] = __uint_as_float(r[0] & 0xFFFF0000u); x[2 * h][2] = __uint_as_float(r[1] << 16); x[2 * h][3] = __uint_as_float(r[1] & 0xFFFF0000u);
            x[2 * h + 1][0] = __uint_as_float(r[2] << 16); x[2 * h + 1][1] = __uint_as_float(r[2] & 0xFFFF0000u); x[2 * h + 1][2] = __uint_as_float(r[3] << 16); x[2 * h + 1][3] = __uint_as_float(r[3] & 0xFFFF0000u);
        }
#pragma unroll
        for (int i = 0; i < 4; ++i) s += x[i][0] + x[i][1] + x[i][2] + x[i][3];
        const float mu = wave_sum(s) * (1.0f / 1024.0f);
        float q = 0.f;
#pragma unroll
        for (int i = 0; i < 4; ++i) { x[i] -= mu; q += x[i][0] * x[i][0] + x[i][1] * x[i][1] + x[i][2] * x[i][2] + x[i][3] * x[i][3]; }
        const float rs = rsqrtf(wave_sum(q) * (1.0f / 1024.0f) + 1e-5f);
#pragma unroll
        for (int h = 0; h < 2; ++h) {
            const f32x4 y0 = x[2 * h] * rs * gv[2 * h] + bv[2 * h], y1 = x[2 * h + 1] * rs * gv[2 * h + 1] + bv[2 * h + 1];
            const size_t o = (size_t)row * 1024 + h * 512 + lane * 8;
            if (XF) { *(f32x4*)(XF + o) = y0; *(f32x4*)(XF + o + 4) = y1; }
            if (XB) { u32x4 pk; pk[0] = cvt_pk_bf16(y0[0], y0[1]); pk[1] = cvt_pk_bf16(y0[2], y0[3]); pk[2] = cvt_pk_bf16(y1[0], y1[1]); pk[3] = cvt_pk_bf16(y1[2], y1[3]); *(u32x4*)(XB + o) = pk; }
        }
    }
}

__device__ __forceinline__ void mlstm_samples(const Params& p, const int tid, int j, int s0, int sstride, const bf16_t* proj, const float* gates, bf16_t* hbuf, LAS float* sm) {
    const int v = tid & 127, dq = tid >> 7, wid = tid >> 6;
    for (int s = s0; s < DEC_BATCH * 8; s += sstride) {
        const int b = s >> 3, h = s & 7; const size_t si = ((size_t)j * DEC_BATCH + b) * 8 + h;
        const float* C0 = p.in[opq_s0(2)] + si * 8192; const float* n0 = p.in[opq_s0(3)] + si * 64;
        float* Cout = p.out + O_SC + si * 8192; float* nout = p.out + O_SN + si * 64;
        const int row0 = MP + b * DEC_SEQ;
        float C[16], nn[16];
#pragma unroll
        for (int jj = 0; jj < 16; ++jj) { C[jj] = C0[(size_t)(dq * 16 + jj) * 128 + v]; nn[jj] = n0[dq * 16 + jj]; }
        float m = p.in[opq_s0(4)][si];
        const float gb_i = p.in[opq_s0(8)][j * 16 + h], gb_f = p.in[opq_s0(8)][j * 16 + 8 + h];
        const float nw = p.in[opq_s0(9)][j * 1024 + h * 128 + v];
        bf16x8 qv[4][2], kv[4][2]; float vv[4], ov[4], gir[4], gfr[4];
#pragma unroll
        for (int t = 0; t < 4; ++t) {
            const bf16_t* pr = proj + (size_t)(row0 + t) * A_INP;
            qv[t][0] = *(const bf16x8*)(pr + h * 64 + dq * 16); qv[t][1] = *(const bf16x8*)(pr + h * 64 + dq * 16 + 8);
            kv[t][0] = *(const bf16x8*)(pr + 512 + h * 64 + dq * 16); kv[t][1] = *(const bf16x8*)(pr + 512 + h * 64 + dq * 16 + 8);
            vv[t] = bf2f(pr[1024 + h * 128 + v]); ov[t] = bf2f(pr[2048 + h * 128 + v]);
            gir[t] = gates[(size_t)(row0 + t) * 32 + h]; gfr[t] = gates[(size_t)(row0 + t) * 32 + 8 + h];
        }
#pragma unroll
        for (int t = 0; t < 4; ++t) {
            LAS float* smt = sm + (t & 1) * 640;
            const float gi = tanh15_(gir[t] + gb_i);
            const float gf = tanh15_(gfr[t] + gb_f);
            const float logf = logsig_(gf);
            const float m_new = fmaxf(logf + m, gi), fd = __expf(logf + m - m_new), iw = __expf(gi - m_new);
            float pnum = 0.f, pden = 0.f;
#pragma unroll
            for (int jj = 0; jj < 16; ++jj) {
                const float kk = bf2f((bf16_t)kv[t][jj >> 3][jj & 7]) * 0.125f, qq = bf2f((bf16_t)qv[t][jj >> 3][jj & 7]);
                C[jj] = fd * C[jj] + iw * kk * vv[t]; nn[jj] = fd * nn[jj] + iw * kk; pnum += C[jj] * qq; pden += nn[jj] * qq;
            }
            smt[dq * 128 + v] = pnum; if (v == 0) smt[512 + dq] = pden;
            __syncthreads();
            const float num = smt[v] + smt[128 + v] + smt[256 + v] + smt[384 + v], den = smt[512] + smt[513] + smt[514] + smt[515];
            const float hh = num / fmaxf(fabsf(den), __expf(-m_new));
            const float ws_ = wave_sum(hh * hh);
            if ((tid & 63) == 0) smt[520 + wid] = ws_;
            __syncthreads();
            const float ms = (smt[520] + smt[521]) * (1.0f / 128.0f);
            if (dq == 0) hbuf[(size_t)(row0 + t) * 1024 + h * 128 + v] = f2bf(hh * rsqrtf(ms + 1e-6f) * nw * ov[t]);
            m = m_new;
        }
#pragma unroll
        for (int jj = 0; jj < 16; ++jj) { Cout[(size_t)(dq * 16 + jj) * 128 + v] = C[jj]; if (v == 0) nout[dq * 16 + jj] = nn[jj]; }
        if (tid == 0) p.out[O_SM + si] = m;
    }
}

template <int CTRL, int ROWMASK>
__device__ __forceinline__ float dpp_f(float identity, float v) {
    return __builtin_bit_cast(float, __builtin_amdgcn_update_dpp(__builtin_bit_cast(int, identity), __builtin_bit_cast(int, v), CTRL, ROWMASK, 0xF, false));
}
__device__ __forceinline__ float wave_scan_add(float v) {
    v += dpp_f<0x111, 0xF>(0.f, v); v += dpp_f<0x112, 0xF>(0.f, v); v += dpp_f<0x114, 0xF>(0.f, v); v += dpp_f<0x118, 0xF>(0.f, v);
    v += dpp_f<0x142, 0xA>(0.f, v);
    v += dpp_f<0x143, 0xC>(0.f, v);
    return v;
}
__device__ __forceinline__ float wave_scan_max(float v) {
    const float ninf = -__builtin_huge_valf();
    v = fmaxf(v, dpp_f<0x111, 0xF>(ninf, v)); v = fmaxf(v, dpp_f<0x112, 0xF>(ninf, v)); v = fmaxf(v, dpp_f<0x114, 0xF>(ninf, v)); v = fmaxf(v, dpp_f<0x118, 0xF>(ninf, v));
    v = fmaxf(v, dpp_f<0x142, 0xA>(ninf, v));
    v = fmaxf(v, dpp_f<0x143, 0xC>(ninf, v));
    return v;
}
__device__ __forceinline__ bf16x8 ldfrag(const LAS bf16_t* buf, int ld, int r0, int k0, int lane) {
    return *(const LAS bf16x8*)(buf + (r0 + (lane & 15)) * ld + k0 + (lane >> 4) * 8);
}
#define MFMA16(a, b, c) __builtin_amdgcn_mfma_f32_16x16x32_bf16((a), (b), (c), 0, 0, 0)
__device__ __forceinline__ int swz(int s, int key) { return (((s >> 3) ^ key) << 3) | (s & 7); }
__device__ __forceinline__ bf16x8 ldfrag_sw(const LAS bf16_t* buf, int ld, int r0, int k0, int lane, int keyshift) {
    const int r = r0 + (lane & 15), key = (r >> keyshift) & 7;
    return *(const LAS bf16x8*)(buf + r * ld + ((((k0 >> 3) + (lane >> 4)) ^ key) << 3));
}

__device__ __forceinline__ void mlstm_chunked(const Params& p, const int tid, int j, int h, int row0, float* Cout, float* nout, float* mout,
                                              const bf16_t* proj, const float* gates, bf16_t* hbuf, LAS unsigned char* lds) {
    const int lane = tid & 63, w = tid >> 6, l15 = lane & 15, quad = lane >> 4;
    LAS bf16_t* Qs = (LAS bf16_t*)lds;
    LAS bf16_t* Ks = Qs + 64 * 72;
    LAS bf16_t* KsT = Ks + 64 * 72;
    LAS bf16_t* Ps = KsT + 64 * 72;
    LAS bf16_t* Vt = Ps + 64 * 72;
    LAS bf16_t* Ct = Vt + 128 * 72;
    LAS float* fs = (LAS float*)(Ct + 128 * 72);
    LAS float* bb = fs; LAS float* aa = fs + 64; LAS float* mt = fs + 128; LAS float* wint = fs + 192; LAS float* wk = fs + 256;
    LAS float* nbuf = fs + 320; LAS float* den = fs + 384; LAS float* rmsp = fs + 448; LAS float* sc = fs + 576;
    for (int i = tid; i < 128 * 72 / 2; i += NTHR) ((LAS unsigned*)Ct)[i] = 0u;
    if (tid < 64) nbuf[tid] = 0.f;
    const float gb_i = p.in[opq_s0(8)][j * 16 + h], gb_f = p.in[opq_s0(8)][j * 16 + 8 + h];
    float m = 0.f;
    const int lt = tid >> 3, part = tid & 7;
    const int tr = w >> 1, tcb = (w & 1) * 4;
    float nwv[4];
#pragma unroll
    for (int i = 0; i < 4; ++i) nwv[i] = p.in[opq_s0(9)][j * 1024 + h * 128 + (tcb + i) * 16 + l15];
    f32x4 Cacc[4];
#pragma unroll
    for (int i = 0; i < 4; ++i) Cacc[i] = (f32x4){0.f, 0.f, 0.f, 0.f};
    bf16x8 qr, kr, vr0, vr1; float gir = 0.f, gfr = 0.f;
    {
        const bf16_t* pr = proj + (size_t)(row0 + lt) * A_INP;
        qr = *(const bf16x8*)(pr + h * 64 + part * 8); kr = *(const bf16x8*)(pr + 512 + h * 64 + part * 8);
        vr0 = *(const bf16x8*)(pr + 1024 + h * 128 + part * 16); vr1 = *(const bf16x8*)(pr + 1024 + h * 128 + part * 16 + 8);
        if (tid < 64) { gir = gates[(size_t)(row0 + tid) * 32 + h]; gfr = gates[(size_t)(row0 + tid) * 32 + 8 + h]; }
    }
    __syncthreads();
    for (int c = 0; c < SEQ / 64; ++c) {
        const int rbase = row0 + c * 64;
        bf16_t og[4][4];
#pragma unroll
        for (int i = 0; i < 4; ++i)
#pragma unroll
            for (int jj = 0; jj < 4; ++jj) og[i][jj] = proj[(size_t)(rbase + tr * 16 + quad * 4 + jj) * A_INP + 2048 + h * 128 + (tcb + i) * 16 + l15];
        *(LAS bf16x8*)(Qs + lt * 72 + part * 8) = qr;
        *(LAS bf16x8*)(Ks + lt * 72 + part * 8) = kr;
#pragma unroll
        for (int e = 0; e < 8; ++e) { Vt[(part * 16 + e) * 72 + swz(lt, part)] = (bf16_t)vr0[e]; Vt[(part * 16 + 8 + e) * 72 + swz(lt, part)] = (bf16_t)vr1[e]; }
        if (w == 0) {
            const float gi = tanh15_(gir + gb_i);
            const float gf = tanh15_(gfr + gb_f);
            float b = logsig_(gf);
            b = wave_scan_add(b);
            const float a = gi - b;
            float pm = a;
            pm = wave_scan_max(pm);
            const float mtv = b + fmaxf(m, pm);
            const float b63 = __shfl(b, 63, 64), m_new = __shfl(mtv, 63, 64);
            bb[lane] = b; aa[lane] = a; mt[lane] = mtv; wint[lane] = __expf(b + m - mtv); wk[lane] = __expf(b63 + a - m_new);
            if (lane == 0) { sc[0] = __expf(b63 + m - m_new); sc[1] = m_new; }
            m = m_new;
        }
        __syncthreads();
        {
            const float sck = 0.125f * wk[lt];
#pragma unroll
            for (int e = 0; e < 8; ++e) KsT[(part * 8 + e) * 72 + swz(lt, part)] = f2bf(bf2f((bf16_t)kr[e]) * sck);
        }
        bf16x8 kq_keep = qr; (void)kq_keep;
        if (c + 1 < SEQ / 64) {
            const bf16_t* pr = proj + (size_t)(rbase + 64 + lt) * A_INP;
            qr = *(const bf16x8*)(pr + h * 64 + part * 8); kr = *(const bf16x8*)(pr + 512 + h * 64 + part * 8);
            vr0 = *(const bf16x8*)(pr + 1024 + h * 128 + part * 16); vr1 = *(const bf16x8*)(pr + 1024 + h * 128 + part * 16 + 8);
            if (tid < 64) { gir = gates[(size_t)(rbase + 64 + tid) * 32 + h]; gfr = gates[(size_t)(rbase + 64 + tid) * 32 + 8 + h]; }
        }
        {
            const int tc0 = (w & 1) * 2;
#pragma unroll
            for (int i = 0; i < 2; ++i) {
                const int tc = tc0 + i;
                f32x4 acc = (f32x4){0.f, 0.f, 0.f, 0.f};
                if (tc <= tr) {
#pragma unroll
                    for (int ks = 0; ks < 64; ks += 32) acc = MFMA16(ldfrag(Qs, 72, tr * 16, ks, lane), ldfrag(Ks, 72, tc * 16, ks, lane), acc);
                }
                const int s = tc * 16 + l15; const float as = aa[s];
#pragma unroll
                for (int jj = 0; jj < 4; ++jj) {
                    const int t = tr * 16 + quad * 4 + jj;
                    const float pv = (s <= t) ? acc[jj] * 0.125f * __expf(bb[t] + as - mt[t]) : 0.f;
                    Ps[t * 72 + s] = f2bf(pv);
                }
            }
        }
        __syncthreads();
        {
            const bf16x8 p8 = *(const LAS bf16x8*)(Ps + lt * 72 + part * 8), q8 = *(const LAS bf16x8*)(Qs + lt * 72 + part * 8);
            float s1 = 0.f, s2 = 0.f;
#pragma unroll
            for (int e = 0; e < 8; ++e) { s1 += bf2f((bf16_t)p8[e]); s2 += bf2f((bf16_t)q8[e]) * nbuf[part * 8 + e]; }
            float dv = s1 + wint[lt] * s2;
            dv = oct_sum(dv);
            if (part == 0) den[lt] = dv;
        }
        f32x4 a1[4], a2[4];
#pragma unroll
        for (int i = 0; i < 4; ++i) { a1[i] = (f32x4){0.f, 0.f, 0.f, 0.f}; a2[i] = (f32x4){0.f, 0.f, 0.f, 0.f}; }
#pragma unroll
        for (int ks = 0; ks < 64; ks += 32) {
            const bf16x8 pa = ldfrag(Ps, 72, tr * 16, ks, lane), qa = ldfrag(Qs, 72, tr * 16, ks, lane);
#pragma unroll
            for (int i = 0; i < 4; ++i) {
                a1[i] = MFMA16(pa, ldfrag_sw(Vt, 72, (tcb + i) * 16, ks, lane, 4), a1[i]);
                a2[i] = MFMA16(qa, ldfrag(Ct, 72, (tcb + i) * 16, ks, lane), a2[i]);
            }
        }
        __syncthreads();
        float hv[4][4];
        {
            float sq[4] = {0.f, 0.f, 0.f, 0.f};
#pragma unroll
            for (int jj = 0; jj < 4; ++jj) {
                const int t = tr * 16 + quad * 4 + jj;
                const float wi = wint[t], rd = 1.0f / fmaxf(fabsf(den[t]), __expf(-mt[t]));
#pragma unroll
                for (int i = 0; i < 4; ++i) { hv[i][jj] = (a1[i][jj] + wi * a2[i][jj]) * rd; sq[jj] += hv[i][jj] * hv[i][jj]; }
            }
#pragma unroll
            for (int jj = 0; jj < 4; ++jj) {
                float s = sq[jj];
                s = row16_sum(s);
                if (l15 == 0) rmsp[(w & 1) * 64 + tr * 16 + quad * 4 + jj] = s;
            }
        }
        {
            const float decay = sc[0];
#pragma unroll
            for (int i = 0; i < 4; ++i) Cacc[i] *= decay;
#pragma unroll
            for (int ks = 0; ks < 64; ks += 32) {
                const bf16x8 ka = ldfrag_sw(KsT, 72, tr * 16, ks, lane, 3);
#pragma unroll
                for (int i = 0; i < 4; ++i) Cacc[i] = MFMA16(ka, ldfrag_sw(Vt, 72, (tcb + i) * 16, ks, lane, 4), Cacc[i]);
            }
#pragma unroll
            for (int i = 0; i < 4; ++i) {
                u32x2 pk; pk[0] = cvt_pk_bf16(Cacc[i][0], Cacc[i][1]); pk[1] = cvt_pk_bf16(Cacc[i][2], Cacc[i][3]);
                *(LAS u32x2*)(Ct + ((tcb + i) * 16 + l15) * 72 + tr * 16 + quad * 4) = pk;
            }
            if (tid < 64) {
                float s = 0.f;
#pragma unroll
                for (int e8 = 0; e8 < 8; ++e8) { const bf16x8 k8 = *(const LAS bf16x8*)(KsT + tid * 72 + e8 * 8);
#pragma unroll
                    for (int e = 0; e < 8; ++e) s += bf2f((bf16_t)k8[e]); }
                nbuf[tid] = decay * nbuf[tid] + s;
            }
        }
        __syncthreads();
#pragma unroll
        for (int jj = 0; jj < 4; ++jj) {
            const int t = tr * 16 + quad * 4 + jj;
            const float rs = rsqrtf((rmsp[t] + rmsp[64 + t]) * (1.0f / 128.0f) + 1e-6f);
#pragma unroll
            for (int i = 0; i < 4; ++i)
                hbuf[(size_t)(rbase + t) * 1024 + h * 128 + (tcb + i) * 16 + l15] = f2bf(hv[i][jj] * rs * nwv[i] * bf2f(og[i][jj]));
        }
    }
#pragma unroll
    for (int i = 0; i < 4; ++i)
#pragma unroll
        for (int jj = 0; jj < 4; ++jj) Cout[(size_t)(tr * 16 + quad * 4 + jj) * 128 + (tcb + i) * 16 + l15] = Cacc[i][jj];
    __syncthreads();
    if (tid < 64) nout[tid] = nbuf[tid];
    if (tid == 0) *mout = m;
    __syncthreads();
}

__device__ __forceinline__ void gdn_conv_phase(const Params& p, const int tid, int jl, const bf16_t* __restrict__ proj, bf16_t* __restrict__ cv) {
    const int o = tid, chb = o * 8, sec = o >> 7;
    f32x2 cw[4][4];
#pragma unroll
    for (int jj = 0; jj < 4; ++jj) { const float* cp = p.in[opq_s0(12)] + ((size_t)jl * 4 + jj) * 4096 + chb;
        const f32x4 c0 = *(const f32x4*)cp, c1 = *(const f32x4*)(cp + 4);
        cw[jj][0] = (f32x2){c0[0], c0[1]}; cw[jj][1] = (f32x2){c0[2], c0[3]}; cw[jj][2] = (f32x2){c1[0], c1[1]}; cw[jj][3] = (f32x2){c1[2], c1[3]}; }
    bf16x8 nxt[11];
#define CONV_LOAD(dst, rg_) do { const int rf_ = (rg_) * 8, ts_ = rf_ & (SEQ - 1); \
        _Pragma("unroll") for (int r = 0; r < 11; ++r) dst[r] = (ts_ - 3 + r) >= 0 ? *(const bf16x8*)(proj + (size_t)(rf_ - 3 + r) * B_INP + chb) : (bf16x8){0, 0, 0, 0, 0, 0, 0, 0}; } while (0)
    int rg = blockIdx.x;
    if (rg < MP / 8) CONV_LOAD(nxt, rg);
    for (; rg < MP / 8; rg += gridDim.x) {
        const int row_first = rg * 8;
        bf16x8 raw[11];
#pragma unroll
        for (int r = 0; r < 11; ++r) raw[r] = nxt[r];
        if (rg + (int)gridDim.x < MP / 8) CONV_LOAD(nxt, rg + (int)gridDim.x);
#pragma unroll
        for (int i = 0; i < 8; ++i) {
            float cvv[8]; float ss = 0.f;
#pragma unroll
            for (int e2 = 0; e2 < 4; ++e2) {
                f32x2 a2 = cw[0][e2] * (f32x2){bf2f((bf16_t)raw[i][2 * e2]), bf2f((bf16_t)raw[i][2 * e2 + 1])};
                a2 += cw[1][e2] * (f32x2){bf2f((bf16_t)raw[i + 1][2 * e2]), bf2f((bf16_t)raw[i + 1][2 * e2 + 1])};
                a2 += cw[2][e2] * (f32x2){bf2f((bf16_t)raw[i + 2][2 * e2]), bf2f((bf16_t)raw[i + 2][2 * e2 + 1])};
                a2 += cw[3][e2] * (f32x2){bf2f((bf16_t)raw[i + 3][2 * e2]), bf2f((bf16_t)raw[i + 3][2 * e2 + 1])};
                const float a0 = a2[0] * sigmoidf_(a2[0]), a1 = a2[1] * sigmoidf_(a2[1]);
                cvv[2 * e2] = a0; cvv[2 * e2 + 1] = a1; ss += a0 * a0 + a1 * a1;
            }
            float rs = 1.0f;
            if (sec < 2) {
                ss = row16_sum(ss);
                rs = rsqrtf(ss + 1e-6f) * (sec == 0 ? 0.08838834764831845f : 1.0f);
            }
            u32x4 pk; pk[0] = cvt_pk_bf16(cvv[0] * rs, cvv[1] * rs); pk[1] = cvt_pk_bf16(cvv[2] * rs, cvv[3] * rs); pk[2] = cvt_pk_bf16(cvv[4] * rs, cvv[5] * rs); pk[3] = cvt_pk_bf16(cvv[6] * rs, cvv[7] * rs);
            *(u32x4*)(cv + (size_t)(row_first + i) * 4096 + chb) = pk;
        }
    }
#undef CONV_LOAD
}

typedef short bf16x4 __attribute__((ext_vector_type(4)));
__device__ __forceinline__ void gdn_chunked(const Params& p, const int tid, int jl, int hv, int row0, float* Sout,
                                            const bf16_t* proj, const bf16_t* cvb, const float* gates, bf16_t* hbuf, LAS unsigned char* lds) {
    const int lane = tid & 63, w = tid >> 6, l15 = lane & 15, quad = lane >> 4, kh = hv >> 1;
    LAS bf16_t* Kb = (LAS bf16_t*)lds;
    LAS bf16_t* Qb = (LAS bf16_t*)(lds + 17408);
    LAS bf16_t* XW = (LAS bf16_t*)(lds + 34816);
    LAS bf16_t* Vb = (LAS bf16_t*)(lds + 53248);
    LAS bf16_t* XU = (LAS bf16_t*)(lds + 70656);
    LAS bf16_t* Mb = (LAS bf16_t*)(lds + 89088);
    LAS float* Md = (LAS float*)(lds + 98304);
    LAS bf16_t* Dv = (LAS bf16_t*)(lds + 102400);
    LAS bf16_t* RT = (LAS bf16_t*)(lds + 104448) + w * 640;
    LAS bf16_t* At = (LAS bf16_t*)(lds + 114688);
    LAS bf16_t* St = (LAS bf16_t*)(lds + 123904);
    LAS float* fs = (LAS float*)(lds + 158720);
    LAS float* Gs = fs; LAS float* betas = fs + 64; LAS float* eGs = fs + 128; LAS float* rmsp = fs + 192; LAS float* sc = fs + 320;
    for (int i = tid; i < 128 * 136 / 2; i += NTHR) ((LAS unsigned*)St)[i] = 0u;
    for (int i = tid; i < 128 * 72 / 2; i += NTHR) { ((LAS unsigned*)XU)[i] = 0u; ((LAS unsigned*)XW)[i] = 0u; }
    const int tr = w >> 1, tcb = (w & 1) * 4;
    float nwv[4];
#pragma unroll
    for (int i = 0; i < 4; ++i) nwv[i] = p.in[opq_s0(15)][jl * 2048 + hv * 128 + (tcb + i) * 16 + l15];
    const float neg_a = -expf(p.in[opq_s0(14)][jl * 16 + hv]), dtb = p.in[opq_s0(13)][jl * 16 + hv];
    f32x4 Sacc[8];
#pragma unroll
    for (int n = 0; n < 8; ++n) Sacc[n] = (f32x4){0.f, 0.f, 0.f, 0.f};
    bf16x8 raw[6]; float gbr = 0.f, gar = 0.f;
#define GDN_PREFETCH(cc) do { \
        _Pragma("unroll") for (int r = 0; r < 6; ++r) { const int idx = tid + r * NTHR, rw = idx / 48, oc = idx - rw * 48, sc3 = oc >> 4, co_ = oc & 15; \
            raw[r] = *(const bf16x8*)(cvb + (size_t)(row0 + (cc) * 64 + rw) * 4096 + (sc3 == 0 ? kh * 128 : (sc3 == 1 ? 1024 + kh * 128 : 2048 + hv * 128)) + co_ * 8); } \
        if (w == 6) { gbr = gates[(size_t)(row0 + (cc) * 64 + lane) * 32 + hv]; gar = gates[(size_t)(row0 + (cc) * 64 + lane) * 32 + 16 + hv]; } } while (0)
    GDN_PREFETCH(0);
    __syncthreads();
    for (int c = 0; c < SEQ / 64; ++c) {
        const int rbase = row0 + c * 64;
        const int tidc = opq_v0(tid);
        const int lane = tidc & 63, w = tidc >> 6, l15 = lane & 15, quad = lane >> 4, tr = w >> 1, tcb = (w & 1) * 4;
        LAS bf16_t* RT = (LAS bf16_t*)(lds + 104448) + w * 640;
        const int tid = tidc;
#pragma unroll
        for (int r = 0; r < 6; ++r) { const int idx = tid + r * NTHR, rw = idx / 48, oc = idx - rw * 48, sc3 = oc >> 4, co_ = oc & 15;
            *(LAS bf16x8*)((sc3 == 0 ? Qb : (sc3 == 1 ? Kb : Vb)) + rw * 136 + co_ * 8) = raw[r]; }
        if (w == 6) {
            const float ax = gar + dtb;
            float G = neg_a * softplus_(ax);
            G = wave_scan_add(G);
            Gs[lane] = G; betas[lane] = sigmoidf_(gbr); eGs[lane] = __expf(G);
            if (lane == 63) { sc[0] = G; sc[1] = __expf(G); }
        }
        __syncthreads();
        const int ts_ = tid >> 3, dp = tid & 7;
        const float sck = __expf(sc[0] - Gs[ts_]);
        const bf16x8 kk0 = *(const LAS bf16x8*)(Kb + ts_ * 136 + dp * 16), kk1 = *(const LAS bf16x8*)(Kb + ts_ * 136 + dp * 16 + 8);
        {
            const int trr = w & 3; const bool isk = w < 4;
            const LAS bf16_t* Ab = isk ? Kb : Qb;
#pragma unroll
            for (int tc = 0; tc < 4; ++tc) {
                f32x4 acc = (f32x4){0.f, 0.f, 0.f, 0.f};
                if (tc <= trr) {
#pragma unroll
                    for (int ks = 0; ks < 128; ks += 32) acc = MFMA16(ldfrag(Ab, 136, trr * 16, ks, lane), ldfrag(Kb, 136, tc * 16, ks, lane), acc);
                }
                const int s = tc * 16 + l15; const float gs = Gs[s];
#pragma unroll
                for (int jj = 0; jj < 4; ++jj) {
                    const int t = trr * 16 + quad * 4 + jj;
                    const float dec = __expf(Gs[t] - gs);
                    if (isk) {
                        const float val = betas[t] * acc[jj] * dec;
                        Mb[t * 72 + s] = (tc < trr) ? f2bf(-val) : (bf16_t)0;
                        if (tc == trr) Md[trr * 256 + (quad * 4 + jj) * 16 + l15] = (s < t) ? val : 0.f;
                    } else At[t * 72 + s] = f2bf((s <= t) ? acc[jj] * dec : 0.f);
                }
            }
        }
        __syncthreads();
        if (w == 0) {
            const LAS float* md = Md + quad * 256;
            float x[16];
#pragma unroll
            for (int i = 0; i < 16; ++i) {
                float a = (i == l15) ? 1.0f : 0.0f;
#pragma unroll
                for (int s = 0; s < i; ++s) a -= md[i * 16 + s] * x[s];
                x[i] = a;
            }
#pragma unroll
            for (int i = 0; i < 16; ++i) Dv[quad * 256 + i * 16 + l15] = f2bf(x[i]);
        }
#pragma unroll
        for (int tb = 0; tb < 4; ++tb) {
            __syncthreads();
            const int t = tb * 16 + l15; const float bt = betas[t], bte = bt * eGs[t];
            f32x4 acc[2];
#pragma unroll
            for (int kind = 0; kind < 2; ++kind) {
                const u32x2 r2 = *(const LAS u32x2*)((kind == 0 ? Vb : Kb) + t * 136 + w * 16 + quad * 4);
                const float sc_ = kind == 0 ? bt : bte;
                acc[kind][0] = sc_ * __uint_as_float(r2[0] << 16); acc[kind][1] = sc_ * __uint_as_float(r2[0] & 0xFFFF0000u);
                acc[kind][2] = sc_ * __uint_as_float(r2[1] << 16); acc[kind][3] = sc_ * __uint_as_float(r2[1] & 0xFFFF0000u);
            }
            if (tb >= 1) {
                const bf16x8 mb0 = ldfrag(Mb, 72, tb * 16, 0, lane);
                acc[0] = MFMA16(ldfrag(XU, 72, w * 16, 0, lane), mb0, acc[0]);
                acc[1] = MFMA16(ldfrag(XW, 72, w * 16, 0, lane), mb0, acc[1]);
            }
            if (tb == 3) {
                const bf16x8 mb1 = ldfrag(Mb, 72, tb * 16, 32, lane);
                acc[0] = MFMA16(ldfrag(XU, 72, w * 16, 32, lane), mb1, acc[0]);
                acc[1] = MFMA16(ldfrag(XW, 72, w * 16, 32, lane), mb1, acc[1]);
            }
#pragma unroll
            for (int kind = 0; kind < 2; ++kind)
#pragma unroll
                for (int jj = 0; jj < 4; ++jj) RT[kind * 320 + quad * 80 + jj * 16 + l15] = f2bf(acc[kind][jj]);
            const bf16x8 zz = (bf16x8){0, 0, 0, 0, 0, 0, 0, 0};
            bf16x8 b8 = *(const LAS bf16x8*)(Dv + tb * 256 + l15 * 16 + (quad & 1) * 8);
            const int rto = (l15 >> 2) * 80 + (l15 & 3) * 16 + (quad & 1) * 8;
            bf16x8 a80 = *(const LAS bf16x8*)(RT + rto), a81 = *(const LAS bf16x8*)(RT + 320 + rto);
            if (quad >= 2) { a80 = zz; a81 = zz; b8 = zz; }
            const f32x4 x0 = MFMA16(a80, b8, ((f32x4){0.f, 0.f, 0.f, 0.f})), x1 = MFMA16(a81, b8, ((f32x4){0.f, 0.f, 0.f, 0.f}));
#pragma unroll
            for (int jj = 0; jj < 4; ++jj) { XU[(w * 16 + quad * 4 + jj) * 72 + t] = f2bf(x0[jj]); XW[(w * 16 + quad * 4 + jj) * 72 + t] = f2bf(x1[jj]); }
            { u32x2 pk; pk[0] = cvt_pk_bf16(-x1[0], -x1[1]); pk[1] = cvt_pk_bf16(-x1[2], -x1[3]);
              *(LAS u32x2*)(Kb + t * 136 + w * 16 + quad * 4) = pk; }
        }
        __syncthreads();
#pragma unroll
        for (int e = 0; e < 8; ++e) { XW[(dp * 16 + e) * 72 + swz(ts_, dp)] = f2bf(bf2f((bf16_t)kk0[e]) * sck); XW[(dp * 16 + 8 + e) * 72 + swz(ts_, dp)] = f2bf(bf2f((bf16_t)kk1[e]) * sck); }
        if (c + 1 < SEQ / 64) GDN_PREFETCH(c + 1);
        f32x4 vacc[4], oacc[4];
#pragma unroll
        for (int i = 0; i < 4; ++i) {
            oacc[i] = (f32x4){0.f, 0.f, 0.f, 0.f};
            const u32x2 r2 = *(const LAS u32x2*)(XU + ((tcb + i) * 16 + l15) * 72 + tr * 16 + quad * 4);
            vacc[i][0] = __uint_as_float(r2[0] << 16); vacc[i][1] = __uint_as_float(r2[0] & 0xFFFF0000u);
            vacc[i][2] = __uint_as_float(r2[1] << 16); vacc[i][3] = __uint_as_float(r2[1] & 0xFFFF0000u);
        }
#pragma unroll
        for (int ks = 0; ks < 128; ks += 32) {
            const bf16x8 wa = ldfrag(Kb, 136, tr * 16, ks, lane), qa = ldfrag(Qb, 136, tr * 16, ks, lane);
#pragma unroll
            for (int i = 0; i < 4; ++i) { const bf16x8 sb = ldfrag(St, 136, (tcb + i) * 16, ks, lane); vacc[i] = MFMA16(wa, sb, vacc[i]); oacc[i] = MFMA16(qa, sb, oacc[i]); }
        }
#pragma unroll
        for (int i = 0; i < 4; ++i) {
#pragma unroll
            for (int jj = 0; jj < 4; ++jj) oacc[i][jj] *= eGs[tr * 16 + quad * 4 + jj];
            u32x2 pk; pk[0] = cvt_pk_bf16(vacc[i][0], vacc[i][1]); pk[1] = cvt_pk_bf16(vacc[i][2], vacc[i][3]);
            *(LAS u32x2*)(XU + ((tcb + i) * 16 + l15) * 72 + tr * 16 + quad * 4) = pk;
        }
        bf16_t zg[4][4];
#pragma unroll
        for (int i = 0; i < 4; ++i)
#pragma unroll
            for (int jj = 0; jj < 4; ++jj) zg[i][jj] = proj[(size_t)(rbase + tr * 16 + quad * 4 + jj) * B_INP + 4096 + hv * 128 + (tcb + i) * 16 + l15];
        __syncthreads();
#pragma unroll
        for (int ks = 0; ks < 64; ks += 32) {
            const bf16x8 aa = ldfrag(At, 72, tr * 16, ks, lane);
#pragma unroll
            for (int i = 0; i < 4; ++i) oacc[i] = MFMA16(aa, ldfrag(XU, 72, (tcb + i) * 16, ks, lane), oacc[i]);
        }
#pragma unroll
        for (int jj = 0; jj < 4; ++jj) {
            float s = 0.f;
#pragma unroll
            for (int i = 0; i < 4; ++i) s += oacc[i][jj] * oacc[i][jj];
            s = row16_sum(s);
            if (l15 == 0) rmsp[(w & 1) * 64 + tr * 16 + quad * 4 + jj] = s;
        }
        {
            const float gL = sc[1];
#pragma unroll
            for (int n = 0; n < 8; ++n) Sacc[n] *= gL;
#pragma unroll
            for (int ks = 0; ks < 64; ks += 32) {
                const bf16x8 ka = ldfrag_sw(XW, 72, w * 16, ks, lane, 4);
#pragma unroll
                for (int n = 0; n < 8; ++n) Sacc[n] = MFMA16(ka, ldfrag(XU, 72, n * 16, ks, lane), Sacc[n]);
            }
#pragma unroll
            for (int n = 0; n < 8; ++n) {
                u32x2 pk; pk[0] = cvt_pk_bf16(Sacc[n][0], Sacc[n][1]); pk[1] = cvt_pk_bf16(Sacc[n][2], Sacc[n][3]);
                *(LAS u32x2*)(St + (n * 16 + l15) * 136 + w * 16 + quad * 4) = pk;
            }
        }
        __syncthreads();
#pragma unroll
        for (int jj = 0; jj < 4; ++jj) {
            const int t = tr * 16 + quad * 4 + jj;
            const float rs = rsqrtf((rmsp[t] + rmsp[64 + t]) * (1.0f / 128.0f) + 1e-6f);
#pragma unroll
            for (int i = 0; i < 4; ++i) { const float z = bf2f(zg[i][jj]);
                hbuf[(size_t)(rbase + t) * 2048 + hv * 128 + (tcb + i) * 16 + l15] = f2bf(oacc[i][jj] * rs * nwv[i] * z); }
        }
    }
#undef GDN_PREFETCH
#pragma unroll
    for (int n = 0; n < 8; ++n)
#pragma unroll
        for (int jj = 0; jj < 4; ++jj) Sout[(size_t)(w * 16 + quad * 4 + jj) * 128 + n * 16 + l15] = Sacc[n][jj];
    __syncthreads();
}

#ifndef PROBE_DUP
#define PROBE_DUP 0
#endif
constexpr int GDN_SAMPLE_ITEMS = DEC_BATCH * 16;
__device__ __forceinline__ void gdn_samples(const Params& p, const int tid, int jl, int s0, int sstride, const bf16_t* proj, const float* gates, bf16_t* hbuf, LAS float* sm) {
    const int v = tid & 127, dq = tid >> 7, wid = tid >> 6;
    LAS float* sm_q = sm; LAS float* sm_k = sm + 512; LAS float* sm_v = sm + 1024; LAS float* sm_rk = sm + 1536; LAS float* sm_rq = sm + 2048;
    LAS float* sm_ss = sm + 2560; LAS float* sm_kq = sm + 2600; LAS float* sm_o2 = sm + 2608;
    const float neg_a_base = 0.f; (void)neg_a_base;
    float S[32];
    if (s0 < DEC_BATCH * 16) {
        const float* S0 = p.in[opq_s0(5)] + (((size_t)jl * DEC_BATCH + (s0 >> 4)) * 16 + (s0 & 15)) * 16384;
#pragma unroll
        for (int jj = 0; jj < 32; ++jj) S[jj] = S0[(size_t)(dq * 32 + jj) * 128 + v];
    }
    for (int sx = s0; sx < GDN_SAMPLE_ITEMS; sx += sstride) {
        const int s = sx & (DEC_BATCH * 16 - 1);
        const int b = s >> 4, hv = s & 15, kh = hv >> 1; const size_t si = ((size_t)jl * DEC_BATCH + b) * 16 + hv;
        const int row0 = MP + b * DEC_SEQ;
        float Sn[32];
        const int snx = sx + sstride, sn = snx & (DEC_BATCH * 16 - 1);
        if (snx < GDN_SAMPLE_ITEMS) {
            const float* S0 = p.in[opq_s0(5)] + (((size_t)jl * DEC_BATCH + (sn >> 4)) * 16 + (sn & 15)) * 16384;
#pragma unroll
            for (int jj = 0; jj < 32; ++jj) Sn[jj] = S0[(size_t)(dq * 32 + jj) * 128 + v];
        }
        const int chan = dq == 0 ? kh * 128 + v : (dq == 1 ? 1024 + kh * 128 + v : (dq == 2 ? 2048 + hv * 128 + v : 4096 + hv * 128 + v));
        float xin[4], gb[4], ga[4];
#pragma unroll
        for (int t = 0; t < 4; ++t) { xin[t] = bf2f(proj[(size_t)(row0 + t) * B_INP + chan]); gb[t] = gates[(size_t)(row0 + t) * 32 + hv]; ga[t] = gates[(size_t)(row0 + t) * 32 + 16 + hv]; }
        float c[4];
        if (dq < 3) {
            const float* cw = p.in[opq_s0(12)] + (size_t)jl * 4 * 4096 + chan;
            const float cw0 = cw[0], cw1 = cw[4096], cw2 = cw[2 * 4096], cw3 = cw[3 * 4096];
            const float* conv0 = p.in[opq_s0(6)] + ((size_t)jl * DEC_BATCH + b) * 3 * 4096;
            float x0 = conv0[chan], x1 = conv0[4096 + chan], x2 = conv0[2 * 4096 + chan];
#pragma unroll
            for (int t = 0; t < 4; ++t) { float a = cw0 * x0 + cw1 * x1 + cw2 * x2 + cw3 * xin[t]; x0 = x1; x1 = x2; x2 = xin[t]; c[t] = a * sigmoidf_(a); }
        } else {
#pragma unroll
            for (int t = 0; t < 4; ++t) c[t] = xin[t];
        }
        const float nw = p.in[opq_s0(15)][jl * 2048 + hv * 128 + v];
        const float neg_a = -expf(p.in[opq_s0(14)][jl * 16 + hv]), dtb = p.in[opq_s0(13)][jl * 16 + hv];
        if (dq < 2) {
#pragma unroll
            for (int t = 0; t < 4; ++t) { const float s2 = wave_sum(c[t] * c[t]); if ((tid & 63) == 0) sm_ss[wid * 4 + t] = s2; }
        }
        __syncthreads();
#pragma unroll
        for (int t = 0; t < 4; ++t) {
            if (dq == 0) sm_q[t * 128 + v] = c[t] * rsqrtf(sm_ss[t] + sm_ss[4 + t] + 1e-6f) * 0.08838834764831845f;
            if (dq == 1) sm_k[t * 128 + v] = c[t] * rsqrtf(sm_ss[8 + t] + sm_ss[12 + t] + 1e-6f);
            if (dq == 2) sm_v[t * 128 + v] = c[t];
        }
        __syncthreads();
#pragma unroll
        for (int t = 0; t < 4; ++t) {
            const float beta = sigmoidf_(gb[t]);
            const float ax = ga[t] + dtb;
            const float eg = __expf(neg_a * softplus_(ax));
            const float vvv = sm_v[t * 128 + v];
            float kk[32];
            float pk = 0.f, pq = 0.f, pkq = 0.f;
#pragma unroll
            for (int j4 = 0; j4 < 8; ++j4) {
                const f32x4 k4 = *(const LAS f32x4*)(sm_k + t * 128 + dq * 32 + j4 * 4), q4 = *(const LAS f32x4*)(sm_q + t * 128 + dq * 32 + j4 * 4);
#pragma unroll
                for (int e = 0; e < 4; ++e) { const int jj = j4 * 4 + e; kk[jj] = k4[e]; S[jj] *= eg; pk += S[jj] * k4[e]; pq += S[jj] * q4[e]; pkq += k4[e] * q4[e]; }
            }
            sm_rk[dq * 128 + v] = pk; sm_rq[dq * 128 + v] = pq; if (v == 0) sm_kq[dq] = pkq;
            __syncthreads();
            const float r = vvv - (sm_rk[v] + sm_rk[128 + v] + sm_rk[256 + v] + sm_rk[384 + v]);
            const float kq = sm_kq[0] + sm_kq[1] + sm_kq[2] + sm_kq[3];
            const float o = sm_rq[v] + sm_rq[128 + v] + sm_rq[256 + v] + sm_rq[384 + v] + beta * kq * r;
            const float br = beta * r;
#pragma unroll
            for (int jj = 0; jj < 32; ++jj) S[jj] += kk[jj] * br;
            const float o2 = wave_sum(o * o);
            if ((tid & 63) == 0) sm_o2[wid] = o2;
            __syncthreads();
            if (dq == 3) {
                const float ms = (sm_o2[6] + sm_o2[7]) * (1.0f / 128.0f);
                hbuf[(size_t)(row0 + t) * 2048 + hv * 128 + v] = f2bf(o * rsqrtf(ms + 1e-6f) * nw * c[t]);
            }
        }
        float* Sout = p.out + O_SS + si * 16384;
#pragma unroll
        for (int jj = 0; jj < 32; ++jj) { Sout[(size_t)(dq * 32 + jj) * 128 + v] = S[jj]; S[jj] = Sn[jj]; }
        __syncthreads();
    }
}

template <int NSPLIT  >
__device__ __forceinline__ void mini_gemm(const bf16_t* __restrict__ A, const bf16_t* __restrict__ Bt, int K, int r0, int c0, int tid, int mode,
                                          bf16_t* __restrict__ O, int ldo, bf16_t* __restrict__ T, const bf16_t* __restrict__ X, LAS float* part) {
    const int lane = tid & 63, w = tid >> 6, l15 = lane & 15, quad = lane >> 4;
    const int ksl = K / NSPLIT, kb = (w % NSPLIT) * ksl;
    f32x4 acc[2][4];
#pragma unroll
    for (int i = 0; i < 2; ++i)
#pragma unroll
        for (int n = 0; n < 4; ++n) acc[i][n] = (f32x4){0.f, 0.f, 0.f, 0.f};
    const bf16_t* ap = A + (size_t)(r0 + l15) * K + kb + quad * 8;
    const bf16_t* bp = Bt + (size_t)(c0 + l15) * K + kb + quad * 8;
#pragma unroll 4
    for (int k = 0; k < ksl; k += 32) {
        bf16x8 af[2], bf[4];
#pragma unroll
        for (int i = 0; i < 2; ++i) af[i] = *(const bf16x8*)(ap + (size_t)i * 16 * K + k);
#pragma unroll
        for (int n = 0; n < 4; ++n) bf[n] = *(const bf16x8*)(bp + (size_t)n * 16 * K + k);
#pragma unroll
        for (int i = 0; i < 2; ++i)
#pragma unroll
            for (int n = 0; n < 4; ++n) acc[i][n] = MFMA16(af[i], bf[n], acc[i][n]);
    }
#pragma unroll
    for (int i = 0; i < 2; ++i)
#pragma unroll
        for (int n = 0; n < 4; ++n)
#pragma unroll
            for (int jj = 0; jj < 4; ++jj) part[(w * 8 + i * 4 + n) * 256 + jj * 64 + lane] = acc[i][n][jj];
    __syncthreads();
    const int g0 = (w / NSPLIT) * NSPLIT, me = w % NSPLIT;
#pragma unroll
    for (int tt = 0; tt < 8 / NSPLIT; ++tt) {
        const int tile = me * (8 / NSPLIT) + tt, ti = tile >> 2, tn = tile & 3;
#pragma unroll
        for (int jj = 0; jj < 4; ++jj) {
            float s = 0.f;
#pragma unroll
            for (int q = 0; q < NSPLIT; ++q) s += part[((g0 + q) * 8 + tile) * 256 + jj * 64 + lane];
            const int row = r0 + ti * 16 + quad * 4 + jj, col = c0 + tn * 16 + l15;
            if (mode == 1) { const float a = fmaxf(s, 0.f); O[(size_t)row * ldo + col] = f2bf(a * a); }
            else T[(size_t)row * 1024 + col] = f2bf(ALPHA * bf2f(X[(size_t)row * 1024 + col]) + s);
        }
    }
    __syncthreads();
}

#define XB_TMO      128
#define XB_XCNT(j)  (256  + 64 * (j))
#define XB_XSUB(j)  (1280 + 64 * (j))
#define XB_XGEN(j)  (2304 + 64 * (j))
#define XB_TOP      3328
#define XB_TOPGEN   3392
#define XCD_BAR_WORDS 3456
#define XB_SPIN_CAP (1u << 20)
__device__ __forceinline__ unsigned xb_ld(unsigned* p)              { return __hip_atomic_load(p, __ATOMIC_RELAXED, __HIP_MEMORY_SCOPE_AGENT); }
__device__ __forceinline__ unsigned xb_add(unsigned* p, unsigned v) { return __hip_atomic_fetch_add(p, v, __ATOMIC_RELAXED, __HIP_MEMORY_SCOPE_AGENT); }
__device__ __forceinline__ unsigned xb_xcc_id() { return (unsigned)__builtin_amdgcn_s_getreg((3 << 11) | 20) & 0xFu; }
#define XB_SPIN(cond, bar) do { unsigned _sp = 0; while (cond) { __builtin_amdgcn_s_sleep(1); \
    if ((++_sp & 255u) == 0u) { if (xb_ld(&(bar)[XB_TMO])) break; if (_sp > XB_SPIN_CAP) { atomicAdd(&(bar)[XB_TMO], 1u); break; } } } } while (0)
__device__ __forceinline__ void xcd_barrier_complete(unsigned* bar, unsigned x, unsigned& nloc, unsigned& nx) {
    const unsigned G = gridDim.x * gridDim.y * gridDim.z;
    unsigned sum, cnt, mine, sp = 0u;
    for (;;) {
        sum = 0u; cnt = 0u; mine = 0u;
#pragma unroll
        for (unsigned j = 0; j < 16; ++j) { const unsigned c = xb_ld(&bar[XB_XCNT(j)]); sum += c; cnt += (c > 0u) ? 1u : 0u; mine = (j == x) ? c : mine; }
        if (sum == G) break;
        __builtin_amdgcn_s_sleep(1);
        if ((++sp & 255u) == 0u) { if (xb_ld(&bar[XB_TMO])) break; if (sp > XB_SPIN_CAP) { atomicAdd(&bar[XB_TMO], 1u); break; } }
    }
    nloc = mine > 0u ? mine : 1u; nx = cnt > 0u ? cnt : 1u;
}
__device__ __forceinline__ void xcd_barrier(unsigned* bar, volatile LAS unsigned* st) {
    asm volatile("s_waitcnt vmcnt(0)" ::: "memory");
    __syncthreads();
    if (threadIdx.x == 0) {
        const unsigned x = xb_xcc_id();
        __builtin_amdgcn_s_waitcnt(0);
        unsigned nloc = st[0], nx = st[1];
        if (nloc == 0u) { xcd_barrier_complete(bar, x, nloc, nx); st[0] = nloc; st[1] = nx; }
        const unsigned old = xb_add(&bar[XB_XSUB(x)], 1u);
        const unsigned gen = old / nloc;
        if (old + 1u == (gen + 1u) * nloc) {
            __builtin_amdgcn_fence(__ATOMIC_RELEASE, "agent");
            asm volatile("s_waitcnt vmcnt(0)" ::: "memory");
            const unsigned og = xb_add(&bar[XB_TOP], 1u);
            const unsigned tg = og / nx;
            if (og + 1u == (tg + 1u) * nx) xb_add(&bar[XB_TOPGEN], 1u);
            else XB_SPIN(xb_ld(&bar[XB_TOPGEN]) == tg, bar);
            __builtin_amdgcn_fence(__ATOMIC_ACQUIRE, "agent");
            xb_add(&bar[XB_XGEN(x)], 1u);
            asm volatile("s_waitcnt vmcnt(0)" ::: "memory");
        } else {
            XB_SPIN(xb_ld(&bar[XB_XGEN(x)]) == gen, bar);
            __builtin_amdgcn_fence(__ATOMIC_ACQUIRE, "agent");
            asm volatile("s_waitcnt vmcnt(0)" ::: "memory");
        }
    }
    __syncthreads();
}

__device__ __forceinline__ int opq_s(int x) { asm volatile("" : "+s"(x)); return x; }
__device__ __forceinline__ int opq_v(int x) { asm volatile("" : "+v"(x)); return x; }
#define PIN(i) (p.in[opq_s(i)])
#define WSP(T, off) ((T*)(p.ws + (size_t)opq_s((int)((off) >> 8)) * 256))

__global__ __launch_bounds__(NTHR, 2) void fwd_megakernel(Params p, int ph_lo, int ph_hi, int use_sync) {
    extern __shared__ __attribute__((aligned(16))) unsigned char shm[];
    LAS unsigned char* lds = (LAS unsigned char*)shm;
    LAS float* smf = (LAS float*)shm;
    cg::grid_group grid = cg::this_grid();
#ifndef PROBE_SEL
#define PROBE_SEL -1
#endif
    volatile LAS unsigned* xst = (volatile LAS unsigned*)(lds + LDS_BYTES - 16);
    if (threadIdx.x == 0) { xst[0] = 0u; xst[1] = 0u; (void)xb_add(&((unsigned*)(p.ws + WS_BAR))[XB_XCNT(xb_xcc_id())], 1u); }
    __syncthreads();
    bool first = true; int nsync = 0;
    for (int ph2 = ph_lo * 2; ph2 < ph_hi * 2; ++ph2) {
        const int ph = ph2 >> 1;
        if ((ph2 & 1) && ph != PROBE_SEL) continue;
        if (ph >= 1 && ((ph - 1) & 7) == 1 && ((((ph - 1) >> 3) & 1) == 0)) continue;
        if (use_sync && !first) {
            if (use_sync == 2) grid.sync();
            else xcd_barrier((unsigned*)(p.ws + WS_BAR), xst);
            ++nsync;
        }
        first = false;
        const int tid = opq_v(threadIdx.x);
        if (ph == 0) {
            transpose_w(PIN(7), 1024, A_IN, A_INP, WSP(bf16_t, WS_AIN), smf, blockIdx.x, gridDim.x);
            const float* xp = PIN(0); const float* xs = PIN(1); bf16_t* XB = WSP(bf16_t, WS_XB);
            for (size_t i = (size_t)blockIdx.x * NTHR + tid; i < (size_t)MT * 256; i += (size_t)gridDim.x * NTHR) {
                const f32x4 xv = i < (size_t)MP * 256 ? *(const f32x4*)(xp + i * 4) : *(const f32x4*)(xs + (i - (size_t)MP * 256) * 4);
                u32x2 pk; pk[0] = cvt_pk_bf16(xv[0], xv[1]); pk[1] = cvt_pk_bf16(xv[2], xv[3]); *(u32x2*)(XB + i * 4) = pk;
            }
            continue;
        }
        const int layer = (ph - 1) >> 3, slot = (ph - 1) & 7, kind = slot == 0 ? 0 : (slot == 1 ? 7 : slot - 1), j = layer >> 1; const bool is_a = (layer & 1) == 0;
        if (kind == 0 || kind == 2 || kind == 4 || kind == 5) {
            pg8::Gemm g; g.M = MT; pg8::Epi E; E.gates = nullptr; E.gate_pn = -1; E.ngate = 0; E.O = nullptr; E.ldc = 0; E.T = nullptr; E.X = nullptr; E.act_lo = 0; E.act_hi = 0; E.act_kind = 0;
            if (kind == 0) {
                g.A = WSP(bf16_t, WS_XB); g.K = 1024; E.mode = 0; E.O = WSP(bf16_t, WS_PROJ); E.gates = WSP(float, WS_GATES);
                if (is_a) { g.Bt = WSP(bf16_t, WS_AIN) + (size_t)j * A_INP * 1024; g.N = A_INP; E.ldc = A_INP; E.gate_pn = 12; E.ngate = 16; E.act_lo = 8; E.act_hi = 12; E.act_kind = 1; }
                else      { g.Bt = WSP(bf16_t, WS_BIN) + (size_t)j * B_INP * 1024; g.N = B_INP; E.ldc = B_INP; E.gate_pn = 24; E.ngate = 32; E.act_lo = 16; E.act_hi = 24; E.act_kind = 2; }
            } else if (kind == 2) {
                g.A = WSP(bf16_t, WS_H); g.N = 1024; E.mode = 2; E.T = WSP(bf16_t, WS_T); E.X = WSP(bf16_t, WS_XB);
                if (is_a) { g.Bt = WSP(bf16_t, WS_AOUT) + (size_t)j * 1024 * 1024; g.K = 1024; } else { g.Bt = WSP(bf16_t, WS_BOUT) + (size_t)j * 1024 * 2048; g.K = 2048; }
            } else if (kind == 4) {
                g.A = WSP(bf16_t, WS_XB); g.K = 1024; g.Bt = WSP(bf16_t, WS_W1) + (size_t)layer * 4096 * 1024; g.N = 4096;
                E.mode = 1; E.O = WSP(bf16_t, WS_HID); E.ldc = 4096;
            } else {
                g.A = WSP(bf16_t, WS_HID); g.K = 4096; g.Bt = WSP(bf16_t, WS_W2) + (size_t)layer * 1024 * 4096; g.N = 1024;
                E.mode = 2; E.T = WSP(bf16_t, WS_T); E.X = WSP(bf16_t, WS_XB);
            }
            if (kind != 0) {
                g.M = MP;
                const int wv = tid >> 6;
                for (int c = blockIdx.x; c < 256; c += gridDim.x) {
                    if (kind == 4) mini_gemm<2>(g.A, g.Bt, g.K, MP + (c >> 5) * 64 + (wv >> 2) * 32, (c & 31) * 128 + ((wv >> 1) & 1) * 64, tid, 1, E.O, 4096, nullptr, nullptr, smf);
                    else           mini_gemm<8>(g.A, g.Bt, g.K, MP + (c >> 4) * 32, (c & 15) * 64, tid, 2, nullptr, 0, E.T, E.X, smf);
                }
            }
            pg8::StaticOrder S; S.init(g.M, g.N, gridDim.x, blockIdx.x);
            pg8::gemm_phase(lds, g, S, E, tid);
        } else if (kind == 1) {
            const bf16_t* PROJ = WSP(bf16_t, WS_PROJ); const float* GATES = WSP(float, WS_GATES); bf16_t* HB = WSP(bf16_t, WS_H);
            const int bi = blockIdx.x;
            if (is_a) {
                const int G = gridDim.x, nsb = G > 64 ? G - 64 : G, sb0 = G > 64 ? bi - 64 : bi;
                if (bi < 64) {
                    for (int sq = bi; sq < 64; sq += G) {
                        const int b = sq >> 3, h = sq & 7; const size_t si = ((size_t)j * BATCH + b) * 8 + h;
                        mlstm_chunked(p, tid, j, h, b * SEQ, p.out + O_PC + si * 8192, p.out + O_PN + si * 64, p.out + O_PM + si, PROJ, GATES, HB, lds);
                    }
                }
                if (G <= 64 || bi >= 64) {
                    __syncthreads();
                    mlstm_samples(p, tid, j, sb0, nsb, PROJ, GATES, HB, smf);
                    if (layer == 0) {
                        __syncthreads();
                        const int wb = sb0, wn = nsb;
                        transpose_w(PIN(10), 1024, 1024, 1024, WSP(bf16_t, WS_AOUT), smf, wb, wn);
                        transpose_w(PIN(17), 1024, 4096, 4096, WSP(bf16_t, WS_W1), smf, wb, wn);
                        transpose_w(PIN(18), 4096, 1024, 1024, WSP(bf16_t, WS_W2), smf, wb, wn);
                        transpose_w(PIN(11), 1024, B_IN, B_INP, WSP(bf16_t, WS_BIN), smf, wb, wn);
                        transpose_w(PIN(16), 2048, 1024, 1024, WSP(bf16_t, WS_BOUT), smf, wb, wn);
                        transpose_w(PIN(7) + (size_t)1024 * A_IN, 1024, A_IN, A_INP, WSP(bf16_t, WS_AIN) + (size_t)A_INP * 1024, smf, wb, wn);
                        transpose_w(PIN(10) + (size_t)1024 * 1024, 1024, 1024, 1024, WSP(bf16_t, WS_AOUT) + (size_t)1024 * 1024, smf, wb, wn);
                        transpose_w(PIN(11) + (size_t)1024 * B_IN, 1024, B_IN, B_INP, WSP(bf16_t, WS_BIN) + (size_t)B_INP * 1024, smf, wb, wn);
                        transpose_w(PIN(16) + (size_t)2048 * 1024, 2048, 1024, 1024, WSP(bf16_t, WS_BOUT) + (size_t)1024 * 2048, smf, wb, wn);
                        for (int l = 1; l < 4; ++l) {
                            transpose_w(PIN(17) + (size_t)l * 1024 * 4096, 1024, 4096, 4096, WSP(bf16_t, WS_W1) + (size_t)l * 4096 * 1024, smf, wb, wn);
                            transpose_w(PIN(18) + (size_t)l * 4096 * 1024, 4096, 1024, 1024, WSP(bf16_t, WS_W2) + (size_t)l * 1024 * 4096, smf, wb, wn);
                        }
                    }
                }
            } else {
                const int G = gridDim.x, nsb = G > 128 ? G - 128 : G, sb0 = G > 128 ? bi - 128 : bi;
                if (bi < 128) {
                    for (int sq = bi; sq < 128; sq += G) {
                        const int b = sq >> 4, hv = sq & 15; const size_t si = ((size_t)j * BATCH + b) * 16 + hv;
                        gdn_chunked(p, tid, j, hv, b * SEQ, p.out + O_PS + si * 16384, PROJ, WSP(bf16_t, WS_HID), GATES, HB, lds);
                    }
                }
                if (G <= 128 || bi >= 128) {
                    __syncthreads();
                    gdn_samples(p, tid, j, sb0, nsb, PROJ, GATES, HB, smf);
                    const int nb = nsb, bb = sb0;
                    for (int i = bb * NTHR + tid; i < (BATCH + DEC_BATCH) * 3 * 4096; i += nb * NTHR) {
                        const int c = i & 4095, r = (i >> 12) % 3, b = i / (3 * 4096);
                        if (b < BATCH) p.out[O_PCONV + (((size_t)j * BATCH + b) * 3 + r) * 4096 + c] = bf2f(PROJ[(size_t)(b * SEQ + SEQ - 3 + r) * B_INP + c]);
                        else { const int b2 = b - BATCH; p.out[O_SCONV + (((size_t)j * DEC_BATCH + b2) * 3 + r) * 4096 + c] = bf2f(PROJ[(size_t)(MP + b2 * DEC_SEQ + 1 + r) * B_INP + c]); }
                    }
                }
            }
        } else if (kind == 7) {
            gdn_conv_phase(p, tid, j, WSP(bf16_t, WS_PROJ), WSP(bf16_t, WS_HID));
        } else if (kind == 3) {
            ln_phase(tid, WSP(bf16_t, WS_T), PIN(19) + layer * 1024, PIN(20) + layer * 1024, nullptr, WSP(bf16_t, WS_XB));
        } else {
            if (layer == 3) ln_phase(tid, WSP(bf16_t, WS_T), PIN(21) + layer * 1024, PIN(22) + layer * 1024, p.out + O_YP, nullptr);
            else            ln_phase(tid, WSP(bf16_t, WS_T), PIN(21) + layer * 1024, PIN(22) + layer * 1024, nullptr, WSP(bf16_t, WS_XB));
        }
    }
}
constexpr int N_PHASES = 1 + 4 * 8;

extern "C" void kernel_launch(void* const* d_in, const int* in_sizes, int n_in, void* d_out, int out_size, void* d_ws, size_t ws_size, hipStream_t stream) {
    static int grid = 0;
    if (grid == 0) {
        if (n_in != 23 || (size_t)out_size != O_END || ws_size < WS_END) { fprintf(stderr, "kernel_launch: unexpected shapes n_in %d out %d ws %zu (need %zu)\n", n_in, out_size, ws_size, (size_t)WS_END); grid = -1; return; }
        int dev = 0, cus = 0, per_cu = 0;
        hipGetDevice(&dev);
        hipDeviceGetAttribute(&cus, hipDeviceAttributeMultiprocessorCount, dev);
        hipFuncSetAttribute((const void*)fwd_megakernel, hipFuncAttributeMaxDynamicSharedMemorySize, LDS_BYTES);
        hipOccupancyMaxActiveBlocksPerMultiprocessor(&per_cu, (const void*)fwd_megakernel, NTHR, LDS_BYTES);
        (void)hipGetLastError();
        grid = cus * (per_cu >= 1 ? 1 : 1);
        fprintf(stderr, "kernel_launch: cus %d per_cu %d grid %d\n", cus, per_cu, grid);
    }
    if (grid < 0) return;
    if (hipMemsetAsync((char*)d_ws + WS_BAR, 0, 16384, stream) != hipSuccess) { fprintf(stderr, "kernel_launch: memset of the barrier words failed\n"); return; }
    Params p{};
    for (int i = 0; i < 23; ++i) p.in[i] = (const float*)d_in[i];
    p.out = (float*)d_out; p.ws = (unsigned char*)d_ws;
    int ph_lo = 0, ph_hi = N_PHASES, use_sync = 1;
    void* args[] = {&p, &ph_lo, &ph_hi, &use_sync};
    hipError_t e = hipLaunchCooperativeKernel((const void*)fwd_megakernel, dim3(grid), dim3(NTHR), args, LDS_BYTES, stream);
    if (e != hipSuccess) fprintf(stderr, "cooperative launch failed: %s (grid %d)\n", hipGetErrorString(e), grid);
}
```

```cpp
#include <hip/hip_runtime.h>
#include <hip/hip_cooperative_groups.h>
#include <cstdio>
#include <cstdint>
namespace cg = cooperative_groups;

#define LAS __attribute__((address_space(3)))
typedef unsigned short bf16_t;
typedef short bf16x8 __attribute__((ext_vector_type(8)));
typedef float f32x4 __attribute__((ext_vector_type(4)));
typedef unsigned u32x4 __attribute__((ext_vector_type(4)));
typedef unsigned u32x2 __attribute__((ext_vector_type(2)));

constexpr int D_MODEL = 1024, MP = 16384, MS = 512, MT = MP + MS;
constexpr int SEQ = 2048, DEC_SEQ = 4, BATCH = 8, DEC_BATCH = 128;
constexpr int A_IN = 3088, A_INP = 3328, B_IN = 6176, B_INP = 6400, D_FF = 4096;
constexpr float ALPHA = 1.681792830507429f;
constexpr int NTHR = 512;
constexpr int LDS_BYTES = 161792;

constexpr size_t SZ_AIN = (size_t)A_INP * 1024 * 2, SZ_AOUT = (size_t)1024 * 1024 * 2, SZ_BIN = (size_t)B_INP * 1024 * 2,
                 SZ_BOUT = (size_t)1024 * 2048 * 2, SZ_W1 = (size_t)4096 * 1024 * 2, SZ_W2 = (size_t)1024 * 4096 * 2;
constexpr size_t WS_AIN = 0, WS_AOUT = WS_AIN + 2 * SZ_AIN, WS_BIN = WS_AOUT + 2 * SZ_AOUT, WS_BOUT = WS_BIN + 2 * SZ_BIN,
                 WS_W1 = WS_BOUT + 2 * SZ_BOUT, WS_W2 = WS_W1 + 4 * SZ_W1, WS_XF = WS_W2 + 4 * SZ_W2,
                 WS_XB = WS_XF + (size_t)MT * 1024 * 4, WS_T = WS_XB + (size_t)MT * 1024 * 2, WS_PROJ = WS_T + (size_t)MT * 1024 * 4,
                 WS_H = WS_PROJ + (size_t)MT * B_INP * 2, WS_HID = WS_H + (size_t)MT * 2048 * 2, WS_GATES = WS_HID + (size_t)MT * 4096 * 2,
                 WS_BAR = WS_GATES + (size_t)MT * 32 * 4, WS_END = WS_BAR + 16384;

constexpr size_t O_YP = 0, O_YS = O_YP + (size_t)MP * 1024, O_PC = O_YS + (size_t)MS * 1024, O_PN = O_PC + (size_t)2 * 8 * 8 * 64 * 128,
                 O_PM = O_PN + 2 * 8 * 8 * 64, O_PS = O_PM + 2 * 8 * 8, O_PCONV = O_PS + (size_t)2 * 8 * 16 * 128 * 128,
                 O_SC = O_PCONV + (size_t)2 * 8 * 3 * 4096, O_SN = O_SC + (size_t)2 * 128 * 8 * 64 * 128, O_SM = O_SN + (size_t)2 * 128 * 8 * 64,
                 O_SS = O_SM + 2 * 128 * 8, O_SCONV = O_SS + (size_t)2 * 128 * 16 * 128 * 128, O_END = O_SCONV + (size_t)2 * 128 * 3 * 4096;

struct Params { const float* in[23]; float* out; unsigned char* ws; };

__device__ __forceinline__ float bf2f(bf16_t b) { return __uint_as_float(((unsigned)b) << 16); }

typedef float f32x2 __attribute__((ext_vector_type(2)));
typedef __bf16 bf16x2_t __attribute__((ext_vector_type(2)));
__device__ __forceinline__ unsigned cvt_pk_bf16(float lo, float hi) { f32x2 v = {lo, hi}; bf16x2_t b = __builtin_convertvector(v, bf16x2_t); return __builtin_bit_cast(unsigned, b); }
__device__ __forceinline__ bf16_t f2bf(float f) { return (bf16_t)cvt_pk_bf16(f, 0.f); }
__device__ __forceinline__ float sigmoidf_(float x) { return __builtin_amdgcn_rcpf(1.0f + __expf(-x)); }
__device__ __forceinline__ float tanh15_(float g) { return 15.0f - 30.0f * __builtin_amdgcn_rcpf(1.0f + __expf(g * (2.0f / 15.0f))); }
__device__ __forceinline__ float logsig_(float x) { return -__logf(1.0f + __expf(-x)); }
__device__ __forceinline__ float softplus_(float x) { return x > 20.f ? x : __logf(1.0f + __expf(x)); }
template <int CTRL> __device__ __forceinline__ float dpp_perm(float v) {
    return __builtin_bit_cast(float, __builtin_amdgcn_update_dpp(0, __builtin_bit_cast(int, v), CTRL, 0xF, 0xF, true));
}
__device__ __forceinline__ float row16_sum(float v) { v += dpp_perm<0x128>(v); v += dpp_perm<0x124>(v); v += dpp_perm<0x122>(v); v += dpp_perm<0x121>(v); return v; }
__device__ __forceinline__ float oct_sum(float v) { v += dpp_perm<0xB1>(v); v += dpp_perm<0x4E>(v); v += dpp_perm<0x141>(v); return v; }
__device__ __forceinline__ float wave_sum(float v) { v = row16_sum(v); v += __shfl_xor(v, 16, 64); v += __shfl_xor(v, 32, 64); return v; }

namespace pg8 {
constexpr int BM = 256, BK = 64, HALF = 128, HTB = HALF * BK * 2, STAGE_BYTES = 8 * HTB, NXCD = 8, WGM = 8;
__host__ __device__ __forceinline__ int lds_byte(int r, int c) { const int st = (r >> 4) * 2 + (c >> 5), rr = r & 15, cc = c & 31, ob = rr * 64 + cc * 2; return st * 1024 + (ob ^ (((ob >> 9) & 1) << 5)); }
__host__ __device__ __forceinline__ void stage_rc(int b, int& R, int& C) { const int st = b / 1024, sb = b % 1024, swz = sb ^ (((sb >> 9) & 1) << 5); R = (st >> 1) * 16 + swz / 64; C = (st & 1) * 32 + (swz % 64) / 2; }
__host__ __device__ __forceinline__ int perm32(int rho) { const int n = rho >> 4, i = rho & 15; return 8 * (i >> 2) + 4 * n + (i & 3); }
struct Unit { int pm, pn; };
struct Gemm { const bf16_t* A; const bf16_t* Bt; int M, N, K; };
struct StaticOrder {
    int nM, nN, nwg, G, c;
    __device__ void init(int M, int N, int G_, int c_) { nM = M / BM; nN = N / BM; nwg = nM * nN; G = G_; c = c_; }
    __device__ bool next(int i, Unit& u) const {
        const long L = (long)i * G + c; if (L >= nwg) return false;
        int wgid = (int)L; { const int q = nwg / NXCD, r = nwg % NXCD, xcd = wgid % NXCD, off = wgid / NXCD; wgid = (xcd < r ? xcd * (q + 1) : r * (q + 1) + (xcd - r) * q) + off; }
        const int nig = WGM * nN, gid = wgid / nig, fm = gid * WGM, gsz = (nM - fm) < WGM ? (nM - fm) : WGM;
        u.pm = fm + ((wgid % nig) % gsz); u.pn = (wgid % nig) / gsz; return true;
    }
};

struct Epi { int mode; bf16_t* O; int ldc; float* gates; int gate_pn, ngate; bf16_t* T; const bf16_t* X; int act_lo, act_hi, act_kind; };
__device__ __forceinline__ void epi_run(const Epi& E, const f32x4 (&acc)[2][2][4][2], const Unit& u, int wr, int wc, int fr, int fq);
__device__ __forceinline__ void gemm_phase(LAS unsigned char* lds, const Gemm g, const StaticOrder& S, const Epi& E, const int tid) {
    const int wid = __builtin_amdgcn_readfirstlane(tid >> 6), lane = tid & 63, wr = wid >> 2, wc = wid & 3, fr = lane & 15, fq = lane >> 4;
    const int K = g.K, nt = K / BK;
    unsigned voffA[2], voffB[2];
#pragma unroll
    for (int i = 0; i < 2; ++i) { int R, C; stage_rc(tid * 16 + i * 8192, R, C); const int Rb = (R & ~31) + perm32(R & 31);
        voffA[i] = (unsigned)(R * K + C) * 2u; voffB[i] = (unsigned)(Rb * K + C) * 2u; }
    const size_t kstep = (size_t)(BK * 2);
    const size_t hstep = (size_t)HALF * K * 2;
    const size_t tstep = 2 * hstep;
    const unsigned ldsw = (unsigned)wid * 1024u;
    const int aoff = lds_byte(wr * 64 + fr, fq * 8), boff = lds_byte(wc * 32 + fr, fq * 8);
#define PG8_SA(b, h) (((b) * 2 + (h)) * HTB)
#define PG8_SB(b, h) ((4 + (b) * 2 + (h)) * HTB)
#define PG8_STAGE(bufoff, gbase, voff) do { _Pragma("unroll") for (int _i = 0; _i < 2; ++_i) \
        __builtin_amdgcn_global_load_lds((const unsigned*)((const char*)(gbase) + (voff)[_i]), (LAS unsigned*)(lds + (bufoff) + ldsw + _i * 8192), 16, 0, 0); } while (0)
#define PG8_LDA(dst, b, h) do { _Pragma("unroll") for (int m = 0; m < 4; ++m) _Pragma("unroll") for (int k = 0; k < 2; ++k) dst[m][k] = *(const LAS bf16x8*)(lds + PG8_SA(b, h) + aoff + m * 2048 + k * 1024); } while (0)
#define PG8_LDB(dst, b, h) do { _Pragma("unroll") for (int n = 0; n < 2; ++n) _Pragma("unroll") for (int k = 0; k < 2; ++k) dst[n][k] = *(const LAS bf16x8*)(lds + PG8_SB(b, h) + boff + n * 2048 + k * 1024); } while (0)
#define PG8_MMA(ai, bj, At, Bt) do { __builtin_amdgcn_s_setprio(1); _Pragma("unroll") for (int m = 0; m < 4; ++m) _Pragma("unroll") for (int n = 0; n < 2; ++n) _Pragma("unroll") for (int k = 0; k < 2; ++k) \
        acc[ai][bj][m][n] = __builtin_amdgcn_mfma_f32_16x16x32_bf16(Bt[n][k], At[m][k], acc[ai][bj][m][n], 0, 0, 0); __builtin_amdgcn_s_setprio(0); } while (0)
#define PG8_WAIT_V(n) asm volatile("s_waitcnt vmcnt(" #n ")" ::: "memory")
#define PG8_WAIT_L(n) asm volatile("s_waitcnt lgkmcnt(" #n ")" ::: "memory")
#define PG8_BAR __builtin_amdgcn_s_barrier()
#define PG8_SCHED __builtin_amdgcn_sched_barrier(0)
    Unit cur, nxt; int ui = 0;
    if (!S.next(0, cur)) return;
    f32x4 acc[2][2][4][2];
#pragma unroll
    for (int a = 0; a < 2; ++a)
#pragma unroll
        for (int b = 0; b < 2; ++b)
#pragma unroll
            for (int m = 0; m < 4; ++m)
#pragma unroll
                for (int n = 0; n < 2; ++n) acc[a][b][m][n] = (f32x4){0.f, 0.f, 0.f, 0.f};
    bf16x8 At[4][2], B0[2][2], B1[2][2];
    const char* cA = (const char*)g.A + (size_t)cur.pm * tstep; const char* cB = (const char*)g.Bt + (size_t)cur.pn * tstep;
    PG8_STAGE(PG8_SB(0, 0), cB, voffB); PG8_STAGE(PG8_SB(0, 1), cB + hstep, voffB); PG8_STAGE(PG8_SA(0, 0), cA, voffA); PG8_STAGE(PG8_SA(0, 1), cA + hstep, voffA);
    if (wr == 1) PG8_BAR;
    PG8_WAIT_V(2); PG8_BAR;
    PG8_STAGE(PG8_SB(1, 0), cB + kstep, voffB); PG8_STAGE(PG8_SA(1, 0), cA + kstep, voffA); PG8_STAGE(PG8_SB(1, 1), cB + hstep + kstep, voffB);
    PG8_WAIT_V(6); PG8_BAR;
    for (;;) {
        const bool has_next = S.next(ui + 1, nxt);
        const char* nA = has_next ? (const char*)g.A + (size_t)nxt.pm * tstep : cA; const char* nB = has_next ? (const char*)g.Bt + (size_t)nxt.pn * tstep : cB;
        for (int t = 0; t < nt; t += 2) {
            const bool last = (t == nt - 2);
            const char* a1 = cA + (size_t)(t + 1) * kstep;
            const char* a2 = last ? nA : cA + (size_t)(t + 2) * kstep; const char* b2 = last ? nB : cB + (size_t)(t + 2) * kstep;
            const char* a3 = a2 + kstep; const char* b3 = b2 + kstep;
            PG8_LDB(B0, 0, 0); PG8_LDB(B1, 0, 1); PG8_SCHED; PG8_LDA(At, 0, 0); PG8_STAGE(PG8_SA(1, 1), a1 + hstep, voffA);
            PG8_WAIT_V(8); PG8_WAIT_L(0); PG8_BAR; PG8_MMA(0, 0, At, B0); PG8_MMA(0, 1, At, B1); PG8_BAR; PG8_SCHED;
            PG8_LDA(At, 0, 1); PG8_STAGE(PG8_SB(0, 0), b2, voffB); PG8_STAGE(PG8_SB(0, 1), b2 + hstep, voffB); PG8_STAGE(PG8_SA(0, 0), a2, voffA);
            PG8_WAIT_V(8); PG8_WAIT_L(0); PG8_BAR; PG8_MMA(1, 0, At, B0); PG8_MMA(1, 1, At, B1); PG8_BAR; PG8_SCHED;
            PG8_LDB(B0, 1, 0); PG8_LDB(B1, 1, 1); PG8_SCHED; PG8_LDA(At, 1, 0); PG8_STAGE(PG8_SA(0, 1), a2 + hstep, voffA);
            PG8_WAIT_V(8); PG8_WAIT_L(0); PG8_BAR; PG8_MMA(0, 0, At, B0); PG8_MMA(0, 1, At, B1); PG8_BAR; PG8_SCHED;
            PG8_LDA(At, 1, 1); PG8_STAGE(PG8_SB(1, 0), b3, voffB); PG8_STAGE(PG8_SB(1, 1), b3 + hstep, voffB); PG8_STAGE(PG8_SA(1, 0), a3, voffA);
            PG8_WAIT_V(8); PG8_WAIT_L(0); PG8_BAR; PG8_MMA(1, 0, At, B0); PG8_MMA(1, 1, At, B1); PG8_BAR; PG8_SCHED;
        }
        if (wr == 0) PG8_BAR;
        epi_run(E, acc, cur, wr, wc, fr, fq);
        if (!has_next) break;
#pragma unroll
        for (int a = 0; a < 2; ++a)
#pragma unroll
            for (int b = 0; b < 2; ++b)
#pragma unroll
                for (int m = 0; m < 4; ++m)
#pragma unroll
                    for (int n = 0; n < 2; ++n) acc[a][b][m][n] = (f32x4){0.f, 0.f, 0.f, 0.f};
        cur = nxt; cA = nA; cB = nB; ++ui;
        if (wr == 1) PG8_BAR;
    }
    PG8_WAIT_V(0);
    PG8_BAR;
#undef PG8_SA
#undef PG8_SB
#undef PG8_STAGE
#undef PG8_LDA
#undef PG8_LDB
#undef PG8_MMA
#undef PG8_WAIT_V
#undef PG8_WAIT_L
#undef PG8_BAR
#undef PG8_SCHED
}

__device__ __forceinline__ void epi_run(const Epi& E, const f32x4 (&acc)[2][2][4][2], const Unit& u, int wr, int wc, int fr, int fq) {
    if (E.mode != 2) {
        const int row0 = u.pm * BM + wr * 64 + fr, col0 = u.pn * BM + wc * 32 + 8 * fq;
        const bool dog = (u.pn == E.gate_pn) && (wc == 0) && (8 * fq < E.ngate);
        const bool act = E.mode == 1;
        const int gact = (E.mode == 0 && u.pn >= E.act_lo && u.pn < E.act_hi) ? E.act_kind : 0;
#pragma unroll
        for (int ai = 0; ai < 2; ++ai)
#pragma unroll
            for (int m = 0; m < 4; ++m) {
                const int row = row0 + ai * HALF + m * 16;
                bf16_t* rowp = E.O + (size_t)row * E.ldc + col0;
#pragma unroll
                for (int bj = 0; bj < 2; ++bj) {
                    f32x4 v0 = acc[ai][bj][m][0], v1 = acc[ai][bj][m][1];
                    if (act) {
#pragma unroll
                        for (int e = 0; e < 4; ++e) { float a = fmaxf(v0[e], 0.f), b = fmaxf(v1[e], 0.f); v0[e] = a * a; v1[e] = b * b; }
                    }
                    if (gact) {
#pragma unroll
                        for (int e = 0; e < 4; ++e) { const float s0 = sigmoidf_(v0[e]), s1 = sigmoidf_(v1[e]); v0[e] = gact == 1 ? s0 : v0[e] * s0; v1[e] = gact == 1 ? s1 : v1[e] * s1; }
                    }
                    u32x4 pk; pk[0] = cvt_pk_bf16(v0[0], v0[1]); pk[1] = cvt_pk_bf16(v0[2], v0[3]); pk[2] = cvt_pk_bf16(v1[0], v1[1]); pk[3] = cvt_pk_bf16(v1[2], v1[3]);
                    *(u32x4*)(rowp + bj * HALF) = pk;
                }
                if (dog) { float* gp = E.gates + (size_t)row * 32 + 8 * fq; *(f32x4*)gp = acc[ai][0][m][0]; *(f32x4*)(gp + 4) = acc[ai][0][m][1]; }
            }
    } else {
        const int row0 = u.pm * BM + wr * 64 + fr, col0 = u.pn * BM + wc * 32 + 8 * fq;
#pragma unroll
        for (int ai = 0; ai < 2; ++ai)
#pragma unroll
            for (int m = 0; m < 4; ++m) {
                const size_t ro = (size_t)(row0 + ai * HALF + m * 16) * 1024 + col0;
#pragma unroll
                for (int bj = 0; bj < 2; ++bj) {
                    const u32x4 xr = *(const u32x4*)(E.X + ro + bj * HALF);
                    f32x4 x0, x1;
                    x0[0] = __uint_as_float(xr[0] << 16); x0[1] = __uint_as_float(xr[0] & 0xFFFF0000u); x0[2] = __uint_as_float(xr[1] << 16); x0[3] = __uint_as_float(xr[1] & 0xFFFF0000u);
                    x1[0] = __uint_as_float(xr[2] << 16); x1[1] = __uint_as_float(xr[2] & 0xFFFF0000u); x1[2] = __uint_as_float(xr[3] << 16); x1[3] = __uint_as_float(xr[3] & 0xFFFF0000u);
                    const f32x4 v0 = x0 * ALPHA + acc[ai][bj][m][0], v1 = x1 * ALPHA + acc[ai][bj][m][1];
                    u32x4 pk; pk[0] = cvt_pk_bf16(v0[0], v0[1]); pk[1] = cvt_pk_bf16(v0[2], v0[3]); pk[2] = cvt_pk_bf16(v1[0], v1[1]); pk[3] = cvt_pk_bf16(v1[2], v1[3]);
                    *(u32x4*)(E.T + ro + bj * HALF) = pk;
                }
            }
    }
}
}

__device__ __forceinline__ int opq_s0(int x) { asm volatile("" : "+s"(x)); return x; }
__device__ __forceinline__ int opq_v0(int x) { asm volatile("" : "+v"(x)); return x; }
__device__ __forceinline__ void transpose_w(const float* __restrict__ W, int K, int N, int Npad, bf16_t* __restrict__ Wt, LAS float* sm, int bid, int nb) {
    const int nkt = K / 64, nnt = Npad / 64, ntile = nkt * nnt, tid = opq_v0(threadIdx.x);
    float r[8];
    int tile = bid;
    if (tile < ntile) {
        const int k0 = (tile % nkt) * 64, n0 = (tile / nkt) * 64;
#pragma unroll
        for (int i = 0; i < 8; ++i) { const int idx = tid + i * NTHR, kk = idx >> 6, nn = idx & 63; r[i] = (n0 + nn < N) ? W[(size_t)(k0 + kk) * N + n0 + nn] : 0.f; }
    }
    for (; tile < ntile; tile += nb) {
        const int k0 = (tile % nkt) * 64, n0 = (tile / nkt) * 64;
#pragma unroll
        for (int i = 0; i < 8; ++i) { const int idx = tid + i * NTHR, kk = idx >> 6, nn = idx & 63; sm[kk * 65 + nn] = r[i]; }
        __syncthreads();
        const int nt = tile + nb;
        if (nt < ntile) {
            const int k1 = (nt % nkt) * 64, n1 = (nt / nkt) * 64;
#pragma unroll
            for (int i = 0; i < 8; ++i) { const int idx = tid + i * NTHR, kk = idx >> 6, nn = idx & 63; r[i] = (n1 + nn < N) ? W[(size_t)(k1 + kk) * N + n1 + nn] : 0.f; }
        }
#pragma unroll
        for (int i = 0; i < 4; ++i) { const int idx = tid + i * NTHR, nn = idx >> 5, k2 = (idx & 31) * 2;
            *(unsigned*)(Wt + (size_t)(n0 + nn) * K + k0 + k2) = cvt_pk_bf16(sm[k2 * 65 + nn], sm[(k2 + 1) * 65 + nn]); }
        __syncthreads();
    }
}

__device__ __forceinline__ void ln_phase(const int tid, const bf16_t* __restrict__ T, const float* __restrict__ g, const float* __restrict__ b, float* __restrict__ XF, bf16_t* __restrict__ XB) {
    const int lane = tid & 63, wv = blockIdx.x * 8 + (tid >> 6), nw = gridDim.x * 8;
    f32x4 gv[4], bv[4];
#pragma unroll
    for (int i = 0; i < 4; ++i) { const int c = (i >> 1) * 512 + lane * 8 + (i & 1) * 4; gv[i] = *(const f32x4*)(g + c); bv[i] = *(const f32x4*)(b + c); }
    for (int row = wv; row < MT; row += nw) {
        f32x4 x[4]; float s = 0.f;
#pragma unroll
        for (int h = 0; h < 2; ++h) {
            const u32x4 r = *(const u32x4*)(T + (size_t)row * 1024 + h * 512 + lane * 8);
            x[2 * h][0] = __uint_as_float(r[0] << 16); x[2 * h][1] = __uint_as_float(r[0] & 0xFFFF0000u); x[2 * h][2] = __uint_as_float(r[1] << 16); x[2 * h][3] = __uint_as_float(r[1] & 0xFFFF0000u);
            x[2 * h + 1][0] = __uint_as_float(r[2] << 16); x[2 * h + 1][1] = __uint_as_float(r[2] & 0xFFFF0000u); x[2 * h + 1][2] = __uint_as_float(r[3] << 16); x[2 * h + 1][3] = __uint_as_float(r[3] & 0xFFFF0000u);
        }
#pragma unroll
        for (int i = 0; i < 4; ++i) s += x[i][0] + x[i][1] + x[i][2] + x[i][3];
        const float mu = wave_sum(s) * (1.0f / 1024.0f);
        float q = 0.f;
#pragma unroll
        for (int i = 0; i < 4; ++i) { x[i] -= mu; q += x[i][0] * x[i][0] + x[i][1] * x[i][1] + x[i][2] * x[i][2] + x[i][3] * x[i][3]; }
        const float rs = rsqrtf(wave_sum(q) * (1.0f / 1024.0f) + 1e-5f);
#pragma unroll
        for (int h = 0; h < 2; ++h) {
            const f32x4 y0 = x[2 * h] * rs * gv[2 * h] + bv[2 * h], y1 = x[2 * h + 1] * rs * gv[2 * h + 1] + bv[2 * h + 1];
            const size_t o = (size_t)row * 1024 + h * 512 + lane * 8;
            if (XF) { *(f32x4*)(XF + o) = y0; *(f32x4*)(XF + o + 4) = y1; }
            if (XB) { u32x4 pk; pk[0] = cvt_pk_bf16(y0[0], y0[1]); pk[1] = cvt_pk_bf16(y0[2], y0[3]); pk[2] = cvt_pk_bf16(y1[0], y1[1]); pk[3] = cvt_pk_bf16(y1[2], y1[3]); *(u32x4*)(XB + o) = pk; }
        }
    }
}

__device__ __forceinline__ void mlstm_samples(const Params& p, const int tid, int j, int s0, int sstride, const bf16_t* proj, const float* gates, bf16_t* hbuf, LAS float* sm) {
    const int v = tid & 127, dq = tid >> 7, wid = tid >> 6;
    for (int s = s0; s < DEC_BATCH * 8; s += sstride) {
        const int b = s >> 3, h = s & 7; const size_t si = ((size_t)j * DEC_BATCH + b) * 8 + h;
        const float* C0 = p.in[opq_s0(2)] + si * 8192; const float* n0 = p.in[opq_s0(3)] + si * 64;
        float* Cout = p.out + O_SC + si * 8192; float* nout = p.out + O_SN + si * 64;
        const int row0 = MP + b * DEC_SEQ;
        float C[16], nn[16];
#pragma unroll
        for (int jj = 0; jj < 16; ++jj) { C[jj] = C0[(size_t)(dq * 16 + jj) * 128 + v]; nn[jj] = n0[dq * 16 + jj]; }
        float m = p.in[opq_s0(4)][si];
        const float gb_i = p.in[opq_s0(8)][j * 16 + h], gb_f = p.in[opq_s0(8)][j * 16 + 8 + h];
        const float nw = p.in[opq_s0(9)][j * 1024 + h * 128 + v];
        bf16x8 qv[4][2], kv[4][2]; float vv[4], ov[4], gir[4], gfr[4];
#pragma unroll
        for (int t = 0; t < 4; ++t) {
            const bf16_t* pr = proj + (size_t)(row0 + t) * A_INP;
            qv[t][0] = *(const bf16x8*)(pr + h * 64 + dq * 16); qv[t][1] = *(const bf16x8*)(pr + h * 64 + dq * 16 + 8);
            kv[t][0] = *(const bf16x8*)(pr + 512 + h * 64 + dq * 16); kv[t][1] = *(const bf16x8*)(pr + 512 + h * 64 + dq * 16 + 8);
            vv[t] = bf2f(pr[1024 + h * 128 + v]); ov[t] = bf2f(pr[2048 + h * 128 + v]);
            gir[t] = gates[(size_t)(row0 + t) * 32 + h]; gfr[t] = gates[(size_t)(row0 + t) * 32 + 8 + h];
        }
#pragma unroll
        for (int t = 0; t < 4; ++t) {
            LAS float* smt = sm + (t & 1) * 640;
            const float gi = tanh15_(gir[t] + gb_i);
            const float gf = tanh15_(gfr[t] + gb_f);
            const float logf = logsig_(gf);
            const float m_new = fmaxf(logf + m, gi), fd = __expf(logf + m - m_new), iw = __expf(gi - m_new);
            float pnum = 0.f, pden = 0.f;
#pragma unroll
            for (int jj = 0; jj < 16; ++jj) {
                const float kk = bf2f((bf16_t)kv[t][jj >> 3][jj & 7]) * 0.125f, qq = bf2f((bf16_t)qv[t][jj >> 3][jj & 7]);
                C[jj] = fd * C[jj] + iw * kk * vv[t]; nn[jj] = fd * nn[jj] + iw * kk; pnum += C[jj] * qq; pden += nn[jj] * qq;
            }
            smt[dq * 128 + v] = pnum; if (v == 0) smt[512 + dq] = pden;
            __syncthreads();
            const float num = smt[v] + smt[128 + v] + smt[256 + v] + smt[384 + v], den = smt[512] + smt[513] + smt[514] + smt[515];
            const float hh = num / fmaxf(fabsf(den), __expf(-m_new));
            const float ws_ = wave_sum(hh * hh);
            if ((tid & 63) == 0) smt[520 + wid] = ws_;
            __syncthreads();
            const float ms = (smt[520] + smt[521]) * (1.0f / 128.0f);
            if (dq == 0) hbuf[(size_t)(row0 + t) * 1024 + h * 128 + v] = f2bf(hh * rsqrtf(ms + 1e-6f) * nw * ov[t]);
            m = m_new;
        }
#pragma unroll
        for (int jj = 0; jj < 16; ++jj) { Cout[(size_t)(dq * 16 + jj) * 128 + v] = C[jj]; if (v == 0) nout[dq * 16 + jj] = nn[jj]; }
        if (tid == 0) p.out[O_SM + si] = m;
    }
}

template <int CTRL, int ROWMASK>
__device__ __forceinline__ float dpp_f(float identity, float v) {
    return __builtin_bit_cast(float, __builtin_amdgcn_update_dpp(__builtin_bit_cast(int, identity), __builtin_bit_cast(int, v), CTRL, ROWMASK, 0xF, false));
}
__device__ __forceinline__ float wave_scan_add(float v) {
    v += dpp_f<0x111, 0xF>(0.f, v); v += dpp_f<0x112, 0xF>(0.f, v); v += dpp_f<0x114, 0xF>(0.f, v); v += dpp_f<0x118, 0xF>(0.f, v);
    v += dpp_f<0x142, 0xA>(0.f, v);
    v += dpp_f<0x143, 0xC>(0.f, v);
    return v;
}
__device__ __forceinline__ float wave_scan_max(float v) {
    const float ninf = -__builtin_huge_valf();
    v = fmaxf(v, dpp_f<0x111, 0xF>(ninf, v)); v = fmaxf(v, dpp_f<0x112, 0xF>(ninf, v)); v = fmaxf(v, dpp_f<0x114, 0xF>(ninf, v)); v = fmaxf(v, dpp_f<0x118, 0xF>(ninf, v));
    v = fmaxf(v, dpp_f<0x142, 0xA>(ninf, v));
    v = fmaxf(v, dpp_f<0x143, 0xC>(ninf, v));
    return v;
}
__device__ __forceinline__ bf16x8 ldfrag(const LAS bf16_t* buf, int ld, int r0, int k0, int lane) {
    return *(const LAS bf16x8*)(buf + (r0 + (lane & 15)) * ld + k0 + (lane >> 4) * 8);
}
#define MFMA16(a, b, c) __builtin_amdgcn_mfma_f32_16x16x32_bf16((a), (b), (c), 0, 0, 0)
__device__ __forceinline__ int swz(int s, int key) { return (((s >> 3) ^ key) << 3) | (s & 7); }
__device__ __forceinline__ bf16x8 ldfrag_sw(const LAS bf16_t* buf, int ld, int r0, int k0, int lane, int keyshift) {
    const int r = r0 + (lane & 15), key = (r >> keyshift) & 7;
    return *(const LAS bf16x8*)(buf + r * ld + ((((k0 >> 3) + (lane >> 4)) ^ key) << 3));
}

__device__ __forceinline__ void mlstm_chunked(const Params& p, const int tid, int j, int h, int row0, float* Cout, float* nout, float* mout,
                                              const bf16_t* proj, const float* gates, bf16_t* hbuf, LAS unsigned char* lds) {
    const int lane = tid & 63, w = tid >> 6, l15 = lane & 15, quad = lane >> 4;
    LAS bf16_t* Qs = (LAS bf16_t*)lds;
    LAS bf16_t* Ks = Qs + 64 * 72;
    LAS bf16_t* KsT = Ks + 64 * 72;
    LAS bf16_t* Ps = KsT + 64 * 72;
    LAS bf16_t* Vt = Ps + 64 * 72;
    LAS bf16_t* Ct = Vt + 128 * 72;
    LAS float* fs = (LAS float*)(Ct + 128 * 72);
    LAS float* bb = fs; LAS float* aa = fs + 64; LAS float* mt = fs + 128; LAS float* wint = fs + 192; LAS float* wk = fs + 256;
    LAS float* nbuf = fs + 320; LAS float* den = fs + 384; LAS float* rmsp = fs + 448; LAS float* sc = fs + 576;
    for (int i = tid; i < 128 * 72 / 2; i += NTHR) ((LAS unsigned*)Ct)[i] = 0u;
    if (tid < 64) nbuf[tid] = 0.f;
    const float gb_i = p.in[opq_s0(8)][j * 16 + h], gb_f = p.in[opq_s0(8)][j * 16 + 8 + h];
    float m = 0.f;
    const int lt = tid >> 3, part = tid & 7;
    const int tr = w >> 1, tcb = (w & 1) * 4;
    float nwv[4];
#pragma unroll
    for (int i = 0; i < 4; ++i) nwv[i] = p.in[opq_s0(9)][j * 1024 + h * 128 + (tcb + i) * 16 + l15];
    f32x4 Cacc[4];
#pragma unroll
    for (int i = 0; i < 4; ++i) Cacc[i] = (f32x4){0.f, 0.f, 0.f, 0.f};
    bf16x8 qr, kr, vr0, vr1; float gir = 0.f, gfr = 0.f;
    {
        const bf16_t* pr = proj + (size_t)(row0 + lt) * A_INP;
        qr = *(const bf16x8*)(pr + h * 64 + part * 8); kr = *(const bf16x8*)(pr + 512 + h * 64 + part * 8);
        vr0 = *(const bf16x8*)(pr + 1024 + h * 128 + part * 16); vr1 = *(const bf16x8*)(pr + 1024 + h * 128 + part * 16 + 8);
        if (tid < 64) { gir = gates[(size_t)(row0 + tid) * 32 + h]; gfr = gates[(size_t)(row0 + tid) * 32 + 8 + h]; }
    }
    __syncthreads();
    for (int c = 0; c < SEQ / 64; ++c) {
        const int rbase = row0 + c * 64;
        bf16_t og[4][4];
#pragma unroll
        for (int i = 0; i < 4; ++i)
#pragma unroll
            for (int jj = 0; jj < 4; ++jj) og[i][jj] = proj[(size_t)(rbase + tr * 16 + quad * 4 + jj) * A_INP + 2048 + h * 128 + (tcb + i) * 16 + l15];
        *(LAS bf16x8*)(Qs + lt * 72 + part * 8) = qr;
        *(LAS bf16x8*)(Ks + lt * 72 + part * 8) = kr;
#pragma unroll
        for (int e = 0; e < 8; ++e) { Vt[(part * 16 + e) * 72 + swz(lt, part)] = (bf16_t)vr0[e]; Vt[(part * 16 + 8 + e) * 72 + swz(lt, part)] = (bf16_t)vr1[e]; }
        if (w == 0) {
            const float gi = tanh15_(gir + gb_i);
            const float gf = tanh15_(gfr + gb_f);
            float b = logsig_(gf);
            b = wave_scan_add(b);
            const float a = gi - b;
            float pm = a;
            pm = wave_scan_max(pm);
            const float mtv = b + fmaxf(m, pm);
            const float b63 = __shfl(b, 63, 64), m_new = __shfl(mtv, 63, 64);
            bb[lane] = b; aa[lane] = a; mt[lane] = mtv; wint[lane] = __expf(b + m - mtv); wk[lane] = __expf(b63 + a - m_new);
            if (lane == 0) { sc[0] = __expf(b63 + m - m_new); sc[1] = m_new; }
            m = m_new;
        }
        __syncthreads();
        {
            const float sck = 0.125f * wk[lt];
#pragma unroll
            for (int e = 0; e < 8; ++e) KsT[(part * 8 + e) * 72 + swz(lt, part)] = f2bf(bf2f((bf16_t)kr[e]) * sck);
        }
        bf16x8 kq_keep = qr; (void)kq_keep;
        if (c + 1 < SEQ / 64) {
            const bf16_t* pr = proj + (size_t)(rbase + 64 + lt) * A_INP;
            qr = *(const bf16x8*)(pr + h * 64 + part * 8); kr = *(const bf16x8*)(pr + 512 + h * 64 + part * 8);
            vr0 = *(const bf16x8*)(pr + 1024 + h * 128 + part * 16); vr1 = *(const bf16x8*)(pr + 1024 + h * 128 + part * 16 + 8);
            if (tid < 64) { gir = gates[(size_t)(rbase + 64 + tid) * 32 + h]; gfr = gates[(size_t)(rbase + 64 + tid) * 32 + 8 + h]; }
        }
        {
            const int tc0 = (w & 1) * 2;
#pragma unroll
            for (int i = 0; i < 2; ++i) {
                const int tc = tc0 + i;
                f32x4 acc = (f32x4){0.f, 0.f, 0.f, 0.f};
                if (tc <= tr) {
#pragma unroll
                    for (int ks = 0; ks < 64; ks += 32) acc = MFMA16(ldfrag(Qs, 72, tr * 16, ks, lane), ldfrag(Ks, 72, tc * 16, ks, lane), acc);
                }
                const int s = tc * 16 + l15; const float as = aa[s];
#pragma unroll
                for (int jj = 0; jj < 4; ++jj) {
                    const int t = tr * 16 + quad * 4 + jj;
                    const float pv = (s <= t) ? acc[jj] * 0.125f * __expf(bb[t] + as - mt[t]) : 0.f;
                    Ps[t * 72 + s] = f2bf(pv);
                }
            }
        }
        __syncthreads();
        {
            const bf16x8 p8 = *(const LAS bf16x8*)(Ps + lt * 72 + part * 8), q8 = *(const LAS bf16x8*)(Qs + lt * 72 + part * 8);
            float s1 = 0.f, s2 = 0.f;
#pragma unroll
            for (int e = 0; e < 8; ++e) { s1 += bf2f((bf16_t)p8[e]); s2 += bf2f((bf16_t)q8[e]) * nbuf[part * 8 + e]; }
            float dv = s1 + wint[lt] * s2;
            dv = oct_sum(dv);
            if (part == 0) den[lt] = dv;
        }
        f32x4 a1[4], a2[4];
#pragma unroll
        for (int i = 0; i < 4; ++i) { a1[i] = (f32x4){0.f, 0.f, 0.f, 0.f}; a2[i] = (f32x4){0.f, 0.f, 0.f, 0.f}; }
        __builtin_amdgcn_s_setprio(1);
#pragma unroll
        for (int ks = 0; ks < 64; ks += 32) {
            const bf16x8 pa = ldfrag(Ps, 72, tr * 16, ks, lane), qa = ldfrag(Qs, 72, tr * 16, ks, lane);
#pragma unroll
            for (int i = 0; i < 4; ++i) {
                a1[i] = MFMA16(pa, ldfrag_sw(Vt, 72, (tcb + i) * 16, ks, lane, 4), a1[i]);
                a2[i] = MFMA16(qa, ldfrag(Ct, 72, (tcb + i) * 16, ks, lane), a2[i]);
            }
        }
        __builtin_amdgcn_s_setprio(0);
        __syncthreads();
        float hv[4][4];
        {
            float sq[4] = {0.f, 0.f, 0.f, 0.f};
#pragma unroll
            for (int jj = 0; jj < 4; ++jj) {
                const int t = tr * 16 + quad * 4 + jj;
                const float wi = wint[t], rd = 1.0f / fmaxf(fabsf(den[t]), __expf(-mt[t]));
#pragma unroll
                for (int i = 0; i < 4; ++i) { hv[i][jj] = (a1[i][jj] + wi * a2[i][jj]) * rd; sq[jj] += hv[i][jj] * hv[i][jj]; }
            }
#pragma unroll
            for (int jj = 0; jj < 4; ++jj) {
                float s = sq[jj];
                s = row16_sum(s);
                if (l15 == 0) rmsp[(w & 1) * 64 + tr * 16 + quad * 4 + jj] = s;
            }
        }
        {
            const float decay = sc[0];
#pragma unroll
            for (int i = 0; i < 4; ++i) Cacc[i] *= decay;
#pragma unroll
            for (int ks = 0; ks < 64; ks += 32) {
                const bf16x8 ka = ldfrag_sw(KsT, 72, tr * 16, ks, lane, 3);
#pragma unroll
                for (int i = 0; i < 4; ++i) Cacc[i] = MFMA16(ka, ldfrag_sw(Vt, 72, (tcb + i) * 16, ks, lane, 4), Cacc[i]);
            }
#pragma unroll
            for (int i = 0; i < 4; ++i) {
                u32x2 pk; pk[0] = cvt_pk_bf16(Cacc[i][0], Cacc[i][1]); pk[1] = cvt_pk_bf16(Cacc[i][2], Cacc[i][3]);
                *(LAS u32x2*)(Ct + ((tcb + i) * 16 + l15) * 72 + tr * 16 + quad * 4) = pk;
            }
            if (tid < 64) {
                float s = 0.f;
#pragma unroll
                for (int e8 = 0; e8 < 8; ++e8) { const bf16x8 k8 = *(const LAS bf16x8*)(KsT + tid * 72 + e8 * 8);
#pragma unroll
                    for (int e = 0; e < 8; ++e) s += bf2f((bf16_t)k8[e]); }
                nbuf[tid] = decay * nbuf[tid] + s;
            }
        }
        __syncthreads();
#pragma unroll
        for (int jj = 0; jj < 4; ++jj) {
            const int t = tr * 16 + quad * 4 + jj;
            const float rs = rsqrtf((rmsp[t] + rmsp[64 + t]) * (1.0f / 128.0f) + 1e-6f);
#pragma unroll
            for (int i = 0; i < 4; ++i)
                hbuf[(size_t)(rbase + t) * 1024 + h * 128 + (tcb + i) * 16 + l15] = f2bf(hv[i][jj] * rs * nwv[i] * bf2f(og[i][jj]));
        }
    }
#pragma unroll
    for (int i = 0; i < 4; ++i)
#pragma unroll
        for (int jj = 0; jj < 4; ++jj) Cout[(size_t)(tr * 16 + quad * 4 + jj) * 128 + (tcb + i) * 16 + l15] = Cacc[i][jj];
    __syncthreads();
    if (tid < 64) nout[tid] = nbuf[tid];
    if (tid == 0) *mout = m;
    __syncthreads();
}

__device__ __forceinline__ void gdn_conv_phase(const Params& p, const int tid, int jl, const bf16_t* __restrict__ proj, bf16_t* __restrict__ cv) {
    const int o = tid, chb = o * 8, sec = o >> 7;
    float cw[4][8];
#pragma unroll
    for (int jj = 0; jj < 4; ++jj) { const float* cp = p.in[opq_s0(12)] + ((size_t)jl * 4 + jj) * 4096 + chb;
        const f32x4 c0 = *(const f32x4*)cp, c1 = *(const f32x4*)(cp + 4);
#pragma unroll
        for (int e = 0; e < 4; ++e) { cw[jj][e] = c0[e]; cw[jj][4 + e] = c1[e]; } }
    bf16x8 nxt[11];
#define CONV_LOAD(dst, rg_) do { const int rf_ = (rg_) * 8, ts_ = rf_ & (SEQ - 1); \
        _Pragma("unroll") for (int r = 0; r < 11; ++r) dst[r] = (ts_ - 3 + r) >= 0 ? *(const bf16x8*)(proj + (size_t)(rf_ - 3 + r) * B_INP + chb) : (bf16x8){0, 0, 0, 0, 0, 0, 0, 0}; } while (0)
    int rg = blockIdx.x;
    if (rg < MP / 8) CONV_LOAD(nxt, rg);
    for (; rg < MP / 8; rg += gridDim.x) {
        const int row_first = rg * 8;
        bf16x8 raw[11];
#pragma unroll
        for (int r = 0; r < 11; ++r) raw[r] = nxt[r];
        if (rg + (int)gridDim.x < MP / 8) CONV_LOAD(nxt, rg + (int)gridDim.x);
#pragma unroll
        for (int i = 0; i < 8; ++i) {
            float cvv[8]; float ss = 0.f;
#pragma unroll
            for (int e = 0; e < 8; ++e) {
                float a = cw[0][e] * bf2f((bf16_t)raw[i][e]) + cw[1][e] * bf2f((bf16_t)raw[i + 1][e]) + cw[2][e] * bf2f((bf16_t)raw[i + 2][e]) + cw[3][e] * bf2f((bf16_t)raw[i + 3][e]);
                a = a * sigmoidf_(a); cvv[e] = a; ss += a * a;
            }
            float rs = 1.0f;
            if (sec < 2) {
                ss = row16_sum(ss);
                rs = rsqrtf(ss + 1e-6f) * (sec == 0 ? 0.08838834764831845f : 1.0f);
            }
            u32x4 pk; pk[0] = cvt_pk_bf16(cvv[0] * rs, cvv[1] * rs); pk[1] = cvt_pk_bf16(cvv[2] * rs, cvv[3] * rs); pk[2] = cvt_pk_bf16(cvv[4] * rs, cvv[5] * rs); pk[3] = cvt_pk_bf16(cvv[6] * rs, cvv[7] * rs);
            *(u32x4*)(cv + (size_t)(row_first + i) * 4096 + chb) = pk;
        }
    }
#undef CONV_LOAD
}

typedef short bf16x4 __attribute__((ext_vector_type(4)));
__device__ __forceinline__ void gdn_chunked(const Params& p, const int tid, int jl, int hv, int row0, float* Sout,
                                            const bf16_t* proj, const bf16_t* cvb, const float* gates, bf16_t* hbuf, LAS unsigned char* lds) {
    const int lane = tid & 63, w = tid >> 6, l15 = lane & 15, quad = lane >> 4, kh = hv >> 1;
    LAS bf16_t* Kb = (LAS bf16_t*)lds;
    LAS bf16_t* Qb = (LAS bf16_t*)(lds + 17408);
    LAS bf16_t* XW = (LAS bf16_t*)(lds + 34816);
    LAS bf16_t* Vb = (LAS bf16_t*)(lds + 53248);
    LAS bf16_t* XU = (LAS bf16_t*)(lds + 70656);
    LAS bf16_t* Mb = (LAS bf16_t*)(lds + 89088);
    LAS float* Md = (LAS float*)(lds + 98304);
    LAS bf16_t* Dv = (LAS bf16_t*)(lds + 102400);
    LAS bf16_t* RT = (LAS bf16_t*)(lds + 104448) + w * 640;
    LAS bf16_t* At = (LAS bf16_t*)(lds + 114688);
    LAS bf16_t* St = (LAS bf16_t*)(lds + 123904);
    LAS float* fs = (LAS float*)(lds + 158720);
    LAS float* Gs = fs; LAS float* betas = fs + 64; LAS float* eGs = fs + 128; LAS float* rmsp = fs + 192; LAS float* sc = fs + 320;
    for (int i = tid; i < 128 * 136 / 2; i += NTHR) ((LAS unsigned*)St)[i] = 0u;
    for (int i = tid; i < 128 * 72 / 2; i += NTHR) { ((LAS unsigned*)XU)[i] = 0u; ((LAS unsigned*)XW)[i] = 0u; }
    const int tr = w >> 1, tcb = (w & 1) * 4;
    float nwv[4];
#pragma unroll
    for (int i = 0; i < 4; ++i) nwv[i] = p.in[opq_s0(15)][jl * 2048 + hv * 128 + (tcb + i) * 16 + l15];
    const float neg_a = -expf(p.in[opq_s0(14)][jl * 16 + hv]), dtb = p.in[opq_s0(13)][jl * 16 + hv];
    f32x4 Sacc[8];
#pragma unroll
    for (int n = 0; n < 8; ++n) Sacc[n] = (f32x4){0.f, 0.f, 0.f, 0.f};
    bf16x8 raw[6]; float gbr = 0.f, gar = 0.f;
#define GDN_PREFETCH(cc) do { \
        _Pragma("unroll") for (int r = 0; r < 6; ++r) { const int idx = tid + r * NTHR, rw = idx / 48, oc = idx - rw * 48, sc3 = oc >> 4, co_ = oc & 15; \
            raw[r] = *(const bf16x8*)(cvb + (size_t)(row0 + (cc) * 64 + rw) * 4096 + (sc3 == 0 ? kh * 128 : (sc3 == 1 ? 1024 + kh * 128 : 2048 + hv * 128)) + co_ * 8); } \
        if (w == 6) { gbr = gates[(size_t)(row0 + (cc) * 64 + lane) * 32 + hv]; gar = gates[(size_t)(row0 + (cc) * 64 + lane) * 32 + 16 + hv]; } } while (0)
    GDN_PREFETCH(0);
    __syncthreads();
    for (int c = 0; c < SEQ / 64; ++c) {
        const int rbase = row0 + c * 64;
        const int tidc = opq_v0(tid);
        const int lane = tidc & 63, w = tidc >> 6, l15 = lane & 15, quad = lane >> 4, tr = w >> 1, tcb = (w & 1) * 4;
        LAS bf16_t* RT = (LAS bf16_t*)(lds + 104448) + w * 640;
        const int tid = tidc;
#pragma unroll
        for (int r = 0; r < 6; ++r) { const int idx = tid + r * NTHR, rw = idx / 48, oc = idx - rw * 48, sc3 = oc >> 4, co_ = oc & 15;
            *(LAS bf16x8*)((sc3 == 0 ? Qb : (sc3 == 1 ? Kb : Vb)) + rw * 136 + co_ * 8) = raw[r]; }
        if (w == 6) {
            const float ax = gar + dtb;
            float G = neg_a * softplus_(ax);
            G = wave_scan_add(G);
            Gs[lane] = G; betas[lane] = sigmoidf_(gbr); eGs[lane] = __expf(G);
            if (lane == 63) { sc[0] = G; sc[1] = __expf(G); }
        }
        __syncthreads();
        const int ts_ = tid >> 3, dp = tid & 7;
        const float sck = __expf(sc[0] - Gs[ts_]);
        const bf16x8 kk0 = *(const LAS bf16x8*)(Kb + ts_ * 136 + dp * 16), kk1 = *(const LAS bf16x8*)(Kb + ts_ * 136 + dp * 16 + 8);
        {
            const int trr = w & 3; const bool isk = w < 4;
            const LAS bf16_t* Ab = isk ? Kb : Qb;
#pragma unroll
            for (int tc = 0; tc < 4; ++tc) {
                f32x4 acc = (f32x4){0.f, 0.f, 0.f, 0.f};
                if (tc <= trr) {
#pragma unroll
                    for (int ks = 0; ks < 128; ks += 32) acc = MFMA16(ldfrag(Ab, 136, trr * 16, ks, lane), ldfrag(Kb, 136, tc * 16, ks, lane), acc);
                }
                const int s = tc * 16 + l15; const float gs = Gs[s];
#pragma unroll
                for (int jj = 0; jj < 4; ++jj) {
                    const int t = trr * 16 + quad * 4 + jj;
                    const float dec = __expf(Gs[t] - gs);
                    if (isk) {
                        const float val = betas[t] * acc[jj] * dec;
                        Mb[t * 72 + s] = (tc < trr) ? f2bf(-val) : (bf16_t)0;
                        if (tc == trr) Md[trr * 256 + (quad * 4 + jj) * 16 + l15] = (s < t) ? val : 0.f;
                    } else At[t * 72 + s] = f2bf((s <= t) ? acc[jj] * dec : 0.f);
                }
            }
        }
        __syncthreads();
        if (w == 0) {
            const LAS float* md = Md + quad * 256;
            float x[16];
#pragma unroll
            for (int i = 0; i < 16; ++i) {
                float a = (i == l15) ? 1.0f : 0.0f;
#pragma unroll
                for (int s = 0; s < i; ++s) a -= md[i * 16 + s] * x[s];
                x[i] = a;
            }
#pragma unroll
            for (int i = 0; i < 16; ++i) Dv[quad * 256 + i * 16 + l15] = f2bf(x[i]);
        }
#pragma unroll
        for (int tb = 0; tb < 4; ++tb) {
            __syncthreads();
            const int t = tb * 16 + l15; const float bt = betas[t], bte = bt * eGs[t];
            f32x4 acc[2];
#pragma unroll
            for (int kind = 0; kind < 2; ++kind) {
                const u32x2 r2 = *(const LAS u32x2*)((kind == 0 ? Vb : Kb) + t * 136 + w * 16 + quad * 4);
                const float sc_ = kind == 0 ? bt : bte;
                acc[kind][0] = sc_ * __uint_as_float(r2[0] << 16); acc[kind][1] = sc_ * __uint_as_float(r2[0] & 0xFFFF0000u);
                acc[kind][2] = sc_ * __uint_as_float(r2[1] << 16); acc[kind][3] = sc_ * __uint_as_float(r2[1] & 0xFFFF0000u);
            }
            if (tb >= 1) {
                const bf16x8 mb0 = ldfrag(Mb, 72, tb * 16, 0, lane);
                acc[0] = MFMA16(ldfrag(XU, 72, w * 16, 0, lane), mb0, acc[0]);
                acc[1] = MFMA16(ldfrag(XW, 72, w * 16, 0, lane), mb0, acc[1]);
            }
            if (tb == 3) {
                const bf16x8 mb1 = ldfrag(Mb, 72, tb * 16, 32, lane);
                acc[0] = MFMA16(ldfrag(XU, 72, w * 16, 32, lane), mb1, acc[0]);
                acc[1] = MFMA16(ldfrag(XW, 72, w * 16, 32, lane), mb1, acc[1]);
            }
#pragma unroll
            for (int kind = 0; kind < 2; ++kind)
#pragma unroll
                for (int jj = 0; jj < 4; ++jj) RT[kind * 320 + quad * 80 + jj * 16 + l15] = f2bf(acc[kind][jj]);
            const bf16x8 zz = (bf16x8){0, 0, 0, 0, 0, 0, 0, 0};
            bf16x8 b8 = *(const LAS bf16x8*)(Dv + tb * 256 + l15 * 16 + (quad & 1) * 8);
            const int rto = (l15 >> 2) * 80 + (l15 & 3) * 16 + (quad & 1) * 8;
            bf16x8 a80 = *(const LAS bf16x8*)(RT + rto), a81 = *(const LAS bf16x8*)(RT + 320 + rto);
            if (quad >= 2) { a80 = zz; a81 = zz; b8 = zz; }
            const f32x4 x0 = MFMA16(a80, b8, ((f32x4){0.f, 0.f, 0.f, 0.f})), x1 = MFMA16(a81, b8, ((f32x4){0.f, 0.f, 0.f, 0.f}));
#pragma unroll
            for (int jj = 0; jj < 4; ++jj) { XU[(w * 16 + quad * 4 + jj) * 72 + t] = f2bf(x0[jj]); XW[(w * 16 + quad * 4 + jj) * 72 + t] = f2bf(x1[jj]); }
            { u32x2 pk; pk[0] = cvt_pk_bf16(-x1[0], -x1[1]); pk[1] = cvt_pk_bf16(-x1[2], -x1[3]);
              *(LAS u32x2*)(Kb + t * 136 + w * 16 + quad * 4) = pk; }
        }
        __syncthreads();
#pragma unroll
        for (int e = 0; e < 8; ++e) { XW[(dp * 16 + e) * 72 + swz(ts_, dp)] = f2bf(bf2f((bf16_t)kk0[e]) * sck); XW[(dp * 16 + 8 + e) * 72 + swz(ts_, dp)] = f2bf(bf2f((bf16_t)kk1[e]) * sck); }
        if (c + 1 < SEQ / 64) GDN_PREFETCH(c + 1);
        f32x4 vacc[4], oacc[4];
#pragma unroll
        for (int i = 0; i < 4; ++i) {
            oacc[i] = (f32x4){0.f, 0.f, 0.f, 0.f};
            const u32x2 r2 = *(const LAS u32x2*)(XU + ((tcb + i) * 16 + l15) * 72 + tr * 16 + quad * 4);
            vacc[i][0] = __uint_as_float(r2[0] << 16); vacc[i][1] = __uint_as_float(r2[0] & 0xFFFF0000u);
            vacc[i][2] = __uint_as_float(r2[1] << 16); vacc[i][3] = __uint_as_float(r2[1] & 0xFFFF0000u);
        }
        __builtin_amdgcn_s_setprio(1);
#pragma unroll
        for (int ks = 0; ks < 128; ks += 32) {
            const bf16x8 wa = ldfrag(Kb, 136, tr * 16, ks, lane), qa = ldfrag(Qb, 136, tr * 16, ks, lane);
#pragma unroll
            for (int i = 0; i < 4; ++i) { const bf16x8 sb = ldfrag(St, 136, (tcb + i) * 16, ks, lane); vacc[i] = MFMA16(wa, sb, vacc[i]); oacc[i] = MFMA16(qa, sb, oacc[i]); }
        }
        __builtin_amdgcn_s_setprio(0);
#pragma unroll
        for (int i = 0; i < 4; ++i) {
#pragma unroll
            for (int jj = 0; jj < 4; ++jj) oacc[i][jj] *= eGs[tr * 16 + quad * 4 + jj];
            u32x2 pk; pk[0] = cvt_pk_bf16(vacc[i][0], vacc[i][1]); pk[1] = cvt_pk_bf16(vacc[i][2], vacc[i][3]);
            *(LAS u32x2*)(XU + ((tcb + i) * 16 + l15) * 72 + tr * 16 + quad * 4) = pk;
        }
        bf16_t zg[4][4];
#pragma unroll
        for (int i = 0; i < 4; ++i)
#pragma unroll
            for (int jj = 0; jj < 4; ++jj) zg[i][jj] = proj[(size_t)(rbase + tr * 16 + quad * 4 + jj) * B_INP + 4096 + hv * 128 + (tcb + i) * 16 + l15];
        __syncthreads();
#pragma unroll
        for (int ks = 0; ks < 64; ks += 32) {
            const bf16x8 aa = ldfrag(At, 72, tr * 16, ks, lane);
#pragma unroll
            for (int i = 0; i < 4; ++i) oacc[i] = MFMA16(aa, ldfrag(XU, 72, (tcb + i) * 16, ks, lane), oacc[i]);
        }
#pragma unroll
        for (int jj = 0; jj < 4; ++jj) {
            float s = 0.f;
#pragma unroll
            for (int i = 0; i < 4; ++i) s += oacc[i][jj] * oacc[i][jj];
            s = row16_sum(s);
            if (l15 == 0) rmsp[(w & 1) * 64 + tr * 16 + quad * 4 + jj] = s;
        }
        {
            const float gL = sc[1];
#pragma unroll
            for (int n = 0; n < 8; ++n) Sacc[n] *= gL;
#pragma unroll
            for (int ks = 0; ks < 64; ks += 32) {
                const bf16x8 ka = ldfrag_sw(XW, 72, w * 16, ks, lane, 4);
#pragma unroll
                for (int n = 0; n < 8; ++n) Sacc[n] = MFMA16(ka, ldfrag(XU, 72, n * 16, ks, lane), Sacc[n]);
            }
#pragma unroll
            for (int n = 0; n < 8; ++n) {
                u32x2 pk; pk[0] = cvt_pk_bf16(Sacc[n][0], Sacc[n][1]); pk[1] = cvt_pk_bf16(Sacc[n][2], Sacc[n][3]);
                *(LAS u32x2*)(St + (n * 16 + l15) * 136 + w * 16 + quad * 4) = pk;
            }
        }
        __syncthreads();
#pragma unroll
        for (int jj = 0; jj < 4; ++jj) {
            const int t = tr * 16 + quad * 4 + jj;
            const float rs = rsqrtf((rmsp[t] + rmsp[64 + t]) * (1.0f / 128.0f) + 1e-6f);
#pragma unroll
            for (int i = 0; i < 4; ++i) { const float z = bf2f(zg[i][jj]);
                hbuf[(size_t)(rbase + t) * 2048 + hv * 128 + (tcb + i) * 16 + l15] = f2bf(oacc[i][jj] * rs * nwv[i] * z); }
        }
    }
#undef GDN_PREFETCH
#pragma unroll
    for (int n = 0; n < 8; ++n)
#pragma unroll
        for (int jj = 0; jj < 4; ++jj) Sout[(size_t)(w * 16 + quad * 4 + jj) * 128 + n * 16 + l15] = Sacc[n][jj];
    __syncthreads();
}

#ifndef PROBE_DUP
#define PROBE_DUP 0
#endif
constexpr int GDN_SAMPLE_ITEMS = DEC_BATCH * 16;
__device__ __forceinline__ void gdn_samples(const Params& p, const int tid, int jl, int s0, int sstride, const bf16_t* proj, const float* gates, bf16_t* hbuf, LAS float* sm) {
    const int v = tid & 127, dq = tid >> 7, wid = tid >> 6;
    LAS float* sm_q = sm; LAS float* sm_k = sm + 512; LAS float* sm_v = sm + 1024; LAS float* sm_rk = sm + 1536; LAS float* sm_rq = sm + 2048;
    LAS float* sm_ss = sm + 2560; LAS float* sm_kq = sm + 2600; LAS float* sm_o2 = sm + 2608;
    const float neg_a_base = 0.f; (void)neg_a_base;
    float S[32];
    if (s0 < DEC_BATCH * 16) {
        const float* S0 = p.in[opq_s0(5)] + (((size_t)jl * DEC_BATCH + (s0 >> 4)) * 16 + (s0 & 15)) * 16384;
#pragma unroll
        for (int jj = 0; jj < 32; ++jj) S[jj] = S0[(size_t)(dq * 32 + jj) * 128 + v];
    }
    for (int sx = s0; sx < GDN_SAMPLE_ITEMS; sx += sstride) {
        const int s = sx & (DEC_BATCH * 16 - 1);
        const int b = s >> 4, hv = s & 15, kh = hv >> 1; const size_t si = ((size_t)jl * DEC_BATCH + b) * 16 + hv;
        const int row0 = MP + b * DEC_SEQ;
        float Sn[32];
        const int snx = sx + sstride, sn = snx & (DEC_BATCH * 16 - 1);
        if (snx < GDN_SAMPLE_ITEMS) {
            const float* S0 = p.in[opq_s0(5)] + (((size_t)jl * DEC_BATCH + (sn >> 4)) * 16 + (sn & 15)) * 16384;
#pragma unroll
            for (int jj = 0; jj < 32; ++jj) Sn[jj] = S0[(size_t)(dq * 32 + jj) * 128 + v];
        }
        const int chan = dq == 0 ? kh * 128 + v : (dq == 1 ? 1024 + kh * 128 + v : (dq == 2 ? 2048 + hv * 128 + v : 4096 + hv * 128 + v));
        float xin[4], gb[4], ga[4];
#pragma unroll
        for (int t = 0; t < 4; ++t) { xin[t] = bf2f(proj[(size_t)(row0 + t) * B_INP + chan]); gb[t] = gates[(size_t)(row0 + t) * 32 + hv]; ga[t] = gates[(size_t)(row0 + t) * 32 + 16 + hv]; }
        float c[4];
        if (dq < 3) {
            const float* cw = p.in[opq_s0(12)] + (size_t)jl * 4 * 4096 + chan;
            const float cw0 = cw[0], cw1 = cw[4096], cw2 = cw[2 * 4096], cw3 = cw[3 * 4096];
            const float* conv0 = p.in[opq_s0(6)] + ((size_t)jl * DEC_BATCH + b) * 3 * 4096;
            float x0 = conv0[chan], x1 = conv0[4096 + chan], x2 = conv0[2 * 4096 + chan];
#pragma unroll
            for (int t = 0; t < 4; ++t) { float a = cw0 * x0 + cw1 * x1 + cw2 * x2 + cw3 * xin[t]; x0 = x1; x1 = x2; x2 = xin[t]; c[t] = a * sigmoidf_(a); }
        } else {
#pragma unroll
            for (int t = 0; t < 4; ++t) c[t] = xin[t];
        }
        const float nw = p.in[opq_s0(15)][jl * 2048 + hv * 128 + v];
        const float neg_a = -expf(p.in[opq_s0(14)][jl * 16 + hv]), dtb = p.in[opq_s0(13)][jl * 16 + hv];
        if (dq < 2) {
#pragma unroll
            for (int t = 0; t < 4; ++t) { const float s2 = wave_sum(c[t] * c[t]); if ((tid & 63) == 0) sm_ss[wid * 4 + t] = s2; }
        }
        __syncthreads();
#pragma unroll
        for (int t = 0; t < 4; ++t) {
            if (dq == 0) sm_q[t * 128 + v] = c[t] * rsqrtf(sm_ss[t] + sm_ss[4 + t] + 1e-6f) * 0.08838834764831845f;
            if (dq == 1) sm_k[t * 128 + v] = c[t] * rsqrtf(sm_ss[8 + t] + sm_ss[12 + t] + 1e-6f);
            if (dq == 2) sm_v[t * 128 + v] = c[t];
        }
        __syncthreads();
#pragma unroll
        for (int t = 0; t < 4; ++t) {
            const float beta = sigmoidf_(gb[t]);
            const float ax = ga[t] + dtb;
            const float eg = __expf(neg_a * softplus_(ax));
            const float vvv = sm_v[t * 128 + v];
            float kk[32];
            float pk = 0.f, pq = 0.f, pkq = 0.f;
#pragma unroll
            for (int j4 = 0; j4 < 8; ++j4) {
                const f32x4 k4 = *(const LAS f32x4*)(sm_k + t * 128 + dq * 32 + j4 * 4), q4 = *(const LAS f32x4*)(sm_q + t * 128 + dq * 32 + j4 * 4);
#pragma unroll
                for (int e = 0; e < 4; ++e) { const int jj = j4 * 4 + e; kk[jj] = k4[e]; S[jj] *= eg; pk += S[jj] * k4[e]; pq += S[jj] * q4[e]; pkq += k4[e] * q4[e]; }
            }
            sm_rk[dq * 128 + v] = pk; sm_rq[dq * 128 + v] = pq; if (v == 0) sm_kq[dq] = pkq;
            __syncthreads();
            const float r = vvv - (sm_rk[v] + sm_rk[128 + v] + sm_rk[256 + v] + sm_rk[384 + v]);
            const float kq = sm_kq[0] + sm_kq[1] + sm_kq[2] + sm_kq[3];
            const float o = sm_rq[v] + sm_rq[128 + v] + sm_rq[256 + v] + sm_rq[384 + v] + beta * kq * r;
            const float br = beta * r;
#pragma unroll
            for (int jj = 0; jj < 32; ++jj) S[jj] += kk[jj] * br;
            const float o2 = wave_sum(o * o);
            if ((tid & 63) == 0) sm_o2[wid] = o2;
            __syncthreads();
            if (dq == 3) {
                const float ms = (sm_o2[6] + sm_o2[7]) * (1.0f / 128.0f);
                hbuf[(size_t)(row0 + t) * 2048 + hv * 128 + v] = f2bf(o * rsqrtf(ms + 1e-6f) * nw * c[t]);
            }
        }
        float* Sout = p.out + O_SS + si * 16384;
#pragma unroll
        for (int jj = 0; jj < 32; ++jj) { Sout[(size_t)(dq * 32 + jj) * 128 + v] = S[jj]; S[jj] = Sn[jj]; }
        __syncthreads();
    }
}

template <int NSPLIT  >
__device__ __forceinline__ void mini_gemm(const bf16_t* __restrict__ A, const bf16_t* __restrict__ Bt, int K, int r0, int c0, int tid, int mode,
                                          bf16_t* __restrict__ O, int ldo, bf16_t* __restrict__ T, const bf16_t* __restrict__ X, LAS float* part) {
    const int lane = tid & 63, w = tid >> 6, l15 = lane & 15, quad = lane >> 4;
    const int ksl = K / NSPLIT, kb = (w % NSPLIT) * ksl;
    f32x4 acc[2][4];
#pragma unroll
    for (int i = 0; i < 2; ++i)
#pragma unroll
        for (int n = 0; n < 4; ++n) acc[i][n] = (f32x4){0.f, 0.f, 0.f, 0.f};
    const bf16_t* ap = A + (size_t)(r0 + l15) * K + kb + quad * 8;
    const bf16_t* bp = Bt + (size_t)(c0 + l15) * K + kb + quad * 8;
#pragma unroll 4
    for (int k = 0; k < ksl; k += 32) {
        bf16x8 af[2], bf[4];
#pragma unroll
        for (int i = 0; i < 2; ++i) af[i] = *(const bf16x8*)(ap + (size_t)i * 16 * K + k);
#pragma unroll
        for (int n = 0; n < 4; ++n) bf[n] = *(const bf16x8*)(bp + (size_t)n * 16 * K + k);
#pragma unroll
        for (int i = 0; i < 2; ++i)
#pragma unroll
            for (int n = 0; n < 4; ++n) acc[i][n] = MFMA16(af[i], bf[n], acc[i][n]);
    }
#pragma unroll
    for (int i = 0; i < 2; ++i)
#pragma unroll
        for (int n = 0; n < 4; ++n)
#pragma unroll
            for (int jj = 0; jj < 4; ++jj) part[(w * 8 + i * 4 + n) * 256 + jj * 64 + lane] = acc[i][n][jj];
    __syncthreads();
    const int g0 = (w / NSPLIT) * NSPLIT, me = w % NSPLIT;
#pragma unroll
    for (int tt = 0; tt < 8 / NSPLIT; ++tt) {
        const int tile = me * (8 / NSPLIT) + tt, ti = tile >> 2, tn = tile & 3;
#pragma unroll
        for (int jj = 0; jj < 4; ++jj) {
            float s = 0.f;
#pragma unroll
            for (int q = 0; q < NSPLIT; ++q) s += part[((g0 + q) * 8 + tile) * 256 + jj * 64 + lane];
            const int row = r0 + ti * 16 + quad * 4 + jj, col = c0 + tn * 16 + l15;
            if (mode == 1) { const float a = fmaxf(s, 0.f); O[(size_t)row * ldo + col] = f2bf(a * a); }
            else T[(size_t)row * 1024 + col] = f2bf(ALPHA * bf2f(X[(size_t)row * 1024 + col]) + s);
        }
    }
    __syncthreads();
}

#define XB_TMO      128
#define XB_XCNT(j)  (256  + 64 * (j))
#define XB_XSUB(j)  (1280 + 64 * (j))
#define XB_XGEN(j)  (2304 + 64 * (j))
#define XB_TOP      3328
#define XB_TOPGEN   3392
#define XCD_BAR_WORDS 3456
#define XB_SPIN_CAP (1u << 20)
__device__ __forceinline__ unsigned xb_ld(unsigned* p)              { return __hip_atomic_load(p, __ATOMIC_RELAXED, __HIP_MEMORY_SCOPE_AGENT); }
__device__ __forceinline__ unsigned xb_add(unsigned* p, unsigned v) { return __hip_atomic_fetch_add(p, v, __ATOMIC_RELAXED, __HIP_MEMORY_SCOPE_AGENT); }
__device__ __forceinline__ unsigned xb_xcc_id() { return (unsigned)__builtin_amdgcn_s_getreg((3 << 11) | 20) & 0xFu; }
#define XB_SPIN(cond, bar) do { unsigned _sp = 0; while (cond) { __builtin_amdgcn_s_sleep(1); \
    if ((++_sp & 255u) == 0u) { if (xb_ld(&(bar)[XB_TMO])) break; if (_sp > XB_SPIN_CAP) { atomicAdd(&(bar)[XB_TMO], 1u); break; } } } } while (0)
__device__ __forceinline__ void xcd_barrier_complete(unsigned* bar, unsigned x, unsigned& nloc, unsigned& nx) {
    const unsigned G = gridDim.x * gridDim.y * gridDim.z;
    unsigned sum, cnt, mine, sp = 0u;
    for (;;) {
        sum = 0u; cnt = 0u; mine = 0u;
#pragma unroll
        for (unsigned j = 0; j < 16; ++j) { const unsigned c = xb_ld(&bar[XB_XCNT(j)]); sum += c; cnt += (c > 0u) ? 1u : 0u; mine = (j == x) ? c : mine; }
        if (sum == G) break;
        __builtin_amdgcn_s_sleep(1);
        if ((++sp & 255u) == 0u) { if (xb_ld(&bar[XB_TMO])) break; if (sp > XB_SPIN_CAP) { atomicAdd(&bar[XB_TMO], 1u); break; } }
    }
    nloc = mine > 0u ? mine : 1u; nx = cnt > 0u ? cnt : 1u;
}
__device__ __forceinline__ void xcd_barrier(unsigned* bar, volatile LAS unsigned* st) {
    asm volatile("s_waitcnt vmcnt(0)" ::: "memory");
    __syncthreads();
    if (threadIdx.x == 0) {
        const unsigned x = xb_xcc_id();
        __builtin_amdgcn_s_waitcnt(0);
        unsigned nloc = st[0], nx = st[1];
        if (nloc == 0u) { xcd_barrier_complete(bar, x, nloc, nx); st[0] = nloc; st[1] = nx; }
        const unsigned old = xb_add(&bar[XB_XSUB(x)], 1u);
        const unsigned gen = old / nloc;
        if (old + 1u == (gen + 1u) * nloc) {
            __builtin_amdgcn_fence(__ATOMIC_RELEASE, "agent");
            asm volatile("s_waitcnt vmcnt(0)" ::: "memory");
            const unsigned og = xb_add(&bar[XB_TOP], 1u);
            const unsigned tg = og / nx;
            if (og + 1u == (tg + 1u) * nx) xb_add(&bar[XB_TOPGEN], 1u);
            else XB_SPIN(xb_ld(&bar[XB_TOPGEN]) == tg, bar);
            __builtin_amdgcn_fence(__ATOMIC_ACQUIRE, "agent");
            xb_add(&bar[XB_XGEN(x)], 1u);
            asm volatile("s_waitcnt vmcnt(0)" ::: "memory");
        } else {
            XB_SPIN(xb_ld(&bar[XB_XGEN(x)]) == gen, bar);
            __builtin_amdgcn_fence(__ATOMIC_ACQUIRE, "agent");
            asm volatile("s_waitcnt vmcnt(0)" ::: "memory");
        }
    }
    __syncthreads();
}

__device__ __forceinline__ int opq_s(int x) { asm volatile("" : "+s"(x)); return x; }
__device__ __forceinline__ int opq_v(int x) { asm volatile("" : "+v"(x)); return x; }
#define PIN(i) (p.in[opq_s(i)])
#define WSP(T, off) ((T*)(p.ws + (size_t)opq_s((int)((off) >> 8)) * 256))

__global__ __launch_bounds__(NTHR, 2) void fwd_megakernel(Params p, int ph_lo, int ph_hi, int use_sync) {
    extern __shared__ __attribute__((aligned(16))) unsigned char shm[];
    LAS unsigned char* lds = (LAS unsigned char*)shm;
    LAS float* smf = (LAS float*)shm;
    cg::grid_group grid = cg::this_grid();
#ifndef PROBE_SEL
#define PROBE_SEL -1
#endif
    volatile LAS unsigned* xst = (volatile LAS unsigned*)(lds + LDS_BYTES - 16);
    if (threadIdx.x == 0) { xst[0] = 0u; xst[1] = 0u; (void)xb_add(&((unsigned*)(p.ws + WS_BAR))[XB_XCNT(xb_xcc_id())], 1u); }
    __syncthreads();
    bool first = true; int nsync = 0;
    for (int ph2 = ph_lo * 2; ph2 < ph_hi * 2; ++ph2) {
        const int ph = ph2 >> 1;
        if ((ph2 & 1) && ph != PROBE_SEL) continue;
        if (ph >= 1 && ((ph - 1) & 7) == 1 && ((((ph - 1) >> 3) & 1) == 0)) continue;
        if (use_sync && !first) {
            if (use_sync == 2) grid.sync();
            else xcd_barrier((unsigned*)(p.ws + WS_BAR), xst);
            ++nsync;
        }
        first = false;
        const int tid = opq_v(threadIdx.x);
        if (ph == 0) {
            transpose_w(PIN(7), 1024, A_IN, A_INP, WSP(bf16_t, WS_AIN), smf, blockIdx.x, gridDim.x);
            const float* xp = PIN(0); const float* xs = PIN(1); bf16_t* XB = WSP(bf16_t, WS_XB);
            for (size_t i = (size_t)blockIdx.x * NTHR + tid; i < (size_t)MT * 256; i += (size_t)gridDim.x * NTHR) {
                const f32x4 xv = i < (size_t)MP * 256 ? *(const f32x4*)(xp + i * 4) : *(const f32x4*)(xs + (i - (size_t)MP * 256) * 4);
                u32x2 pk; pk[0] = cvt_pk_bf16(xv[0], xv[1]); pk[1] = cvt_pk_bf16(xv[2], xv[3]); *(u32x2*)(XB + i * 4) = pk;
            }
            continue;
        }
        const int layer = (ph - 1) >> 3, slot = (ph - 1) & 7, kind = slot == 0 ? 0 : (slot == 1 ? 7 : slot - 1), j = layer >> 1; const bool is_a = (layer & 1) == 0;
        if (kind == 0 || kind == 2 || kind == 4 || kind == 5) {
            pg8::Gemm g; g.M = MT; pg8::Epi E; E.gates = nullptr; E.gate_pn = -1; E.ngate = 0; E.O = nullptr; E.ldc = 0; E.T = nullptr; E.X = nullptr; E.act_lo = 0; E.act_hi = 0; E.act_kind = 0;
            if (kind == 0) {
                g.A = WSP(bf16_t, WS_XB); g.K = 1024; E.mode = 0; E.O = WSP(bf16_t, WS_PROJ); E.gates = WSP(float, WS_GATES);
                if (is_a) { g.Bt = WSP(bf16_t, WS_AIN) + (size_t)j * A_INP * 1024; g.N = A_INP; E.ldc = A_INP; E.gate_pn = 12; E.ngate = 16; E.act_lo = 8; E.act_hi = 12; E.act_kind = 1; }
                else      { g.Bt = WSP(bf16_t, WS_BIN) + (size_t)j * B_INP * 1024; g.N = B_INP; E.ldc = B_INP; E.gate_pn = 24; E.ngate = 32; E.act_lo = 16; E.act_hi = 24; E.act_kind = 2; }
            } else if (kind == 2) {
                g.A = WSP(bf16_t, WS_H); g.N = 1024; E.mode = 2; E.T = WSP(bf16_t, WS_T); E.X = WSP(bf16_t, WS_XB);
                if (is_a) { g.Bt = WSP(bf16_t, WS_AOUT) + (size_t)j * 1024 * 1024; g.K = 1024; } else { g.Bt = WSP(bf16_t, WS_BOUT) + (size_t)j * 1024 * 2048; g.K = 2048; }
            } else if (kind == 4) {
                g.A = WSP(bf16_t, WS_XB); g.K = 1024; g.Bt = WSP(bf16_t, WS_W1) + (size_t)layer * 4096 * 1024; g.N = 4096;
                E.mode = 1; E.O = WSP(bf16_t, WS_HID); E.ldc = 4096;
            } else {
                g.A = WSP(bf16_t, WS_HID); g.K = 4096; g.Bt = WSP(bf16_t, WS_W2) + (size_t)layer * 1024 * 4096; g.N = 1024;
                E.mode = 2; E.T = WSP(bf16_t, WS_T); E.X = WSP(bf16_t, WS_XB);
            }
            if (kind != 0) {
                g.M = MP;
                const int wv = tid >> 6;
                for (int c = blockIdx.x; c < 256; c += gridDim.x) {
                    if (kind == 4) mini_gemm<2>(g.A, g.Bt, g.K, MP + (c >> 5) * 64 + (wv >> 2) * 32, (c & 31) * 128 + ((wv >> 1) & 1) * 64, tid, 1, E.O, 4096, nullptr, nullptr, smf);
                    else           mini_gemm<8>(g.A, g.Bt, g.K, MP + (c >> 4) * 32, (c & 15) * 64, tid, 2, nullptr, 0, E.T, E.X, smf);
                }
            }
            pg8::StaticOrder S; S.init(g.M, g.N, gridDim.x, blockIdx.x);
            pg8::gemm_phase(lds, g, S, E, tid);
        } else if (kind == 1) {
            const bf16_t* PROJ = WSP(bf16_t, WS_PROJ); const float* GATES = WSP(float, WS_GATES); bf16_t* HB = WSP(bf16_t, WS_H);
            const int bi = blockIdx.x;
            if (is_a) {
                const int G = gridDim.x, nsb = G > 64 ? G - 64 : G, sb0 = G > 64 ? bi - 64 : bi;
                if (bi < 64) {
                    for (int sq = bi; sq < 64; sq += G) {
                        const int b = sq >> 3, h = sq & 7; const size_t si = ((size_t)j * BATCH + b) * 8 + h;
                        mlstm_chunked(p, tid, j, h, b * SEQ, p.out + O_PC + si * 8192, p.out + O_PN + si * 64, p.out + O_PM + si, PROJ, GATES, HB, lds);
                    }
                }
                if (G <= 64 || bi >= 64) {
                    __syncthreads();
                    mlstm_samples(p, tid, j, sb0, nsb, PROJ, GATES, HB, smf);
                    if (layer == 0) {
                        __syncthreads();
                        const int wb = sb0, wn = nsb;
                        transpose_w(PIN(10), 1024, 1024, 1024, WSP(bf16_t, WS_AOUT), smf, wb, wn);
                        transpose_w(PIN(17), 1024, 4096, 4096, WSP(bf16_t, WS_W1), smf, wb, wn);
                        transpose_w(PIN(18), 4096, 1024, 1024, WSP(bf16_t, WS_W2), smf, wb, wn);
                        transpose_w(PIN(11), 1024, B_IN, B_INP, WSP(bf16_t, WS_BIN), smf, wb, wn);
                        transpose_w(PIN(16), 2048, 1024, 1024, WSP(bf16_t, WS_BOUT), smf, wb, wn);
                        transpose_w(PIN(7) + (size_t)1024 * A_IN, 1024, A_IN, A_INP, WSP(bf16_t, WS_AIN) + (size_t)A_INP * 1024, smf, wb, wn);
                        transpose_w(PIN(10) + (size_t)1024 * 1024, 1024, 1024, 1024, WSP(bf16_t, WS_AOUT) + (size_t)1024 * 1024, smf, wb, wn);
                        transpose_w(PIN(11) + (size_t)1024 * B_IN, 1024, B_IN, B_INP, WSP(bf16_t, WS_BIN) + (size_t)B_INP * 1024, smf, wb, wn);
                        transpose_w(PIN(16) + (size_t)2048 * 1024, 2048, 1024, 1024, WSP(bf16_t, WS_BOUT) + (size_t)1024 * 2048, smf, wb, wn);
                        for (int l = 1; l < 4; ++l) {
                            transpose_w(PIN(17) + (size_t)l * 1024 * 4096, 1024, 4096, 4096, WSP(bf16_t, WS_W1) + (size_t)l * 4096 * 1024, smf, wb, wn);
                            transpose_w(PIN(18) + (size_t)l * 4096 * 1024, 4096, 1024, 1024, WSP(bf16_t, WS_W2) + (size_t)l * 1024 * 4096, smf, wb, wn);
                        }
                    }
                }
            } else {
                const int G = gridDim.x, nsb = G > 128 ? G - 128 : G, sb0 = G > 128 ? bi - 128 : bi;
                if (bi < 128) {
                    for (int sq = bi; sq < 128; sq += G) {
                        const int b = sq >> 4, hv = sq & 15; const size_t si = ((size_t)j * BATCH + b) * 16 + hv;
                        gdn_chunked(p, tid, j, hv, b * SEQ, p.out + O_PS + si * 16384, PROJ, WSP(bf16_t, WS_HID), GATES, HB, lds);
                    }
                }
                if (G <= 128 || bi >= 128) {
                    __syncthreads();
                    gdn_samples(p, tid, j, sb0, nsb, PROJ, GATES, HB, smf);
                    const int nb = nsb, bb = sb0;
                    for (int i = bb * NTHR + tid; i < (BATCH + DEC_BATCH) * 3 * 4096; i += nb * NTHR) {
                        const int c = i & 4095, r = (i >> 12) % 3, b = i / (3 * 4096);
                        if (b < BATCH) p.out[O_PCONV + (((size_t)j * BATCH + b) * 3 + r) * 4096 + c] = bf2f(PROJ[(size_t)(b * SEQ + SEQ - 3 + r) * B_INP + c]);
                        else { const int b2 = b - BATCH; p.out[O_SCONV + (((size_t)j * DEC_BATCH + b2) * 3 + r) * 4096 + c] = bf2f(PROJ[(size_t)(MP + b2 * DEC_SEQ + 1 + r) * B_INP + c]); }
                    }
                }
            }
        } else if (kind == 7) {
            gdn_conv_phase(p, tid, j, WSP(bf16_t, WS_PROJ), WSP(bf16_t, WS_HID));
        } else if (kind == 3) {
            ln_phase(tid, WSP(bf16_t, WS_T), PIN(19) + layer * 1024, PIN(20) + layer * 1024, nullptr, WSP(bf16_t, WS_XB));
        } else {
            if (layer == 3) ln_phase(tid, WSP(bf16_t, WS_T), PIN(21) + layer * 1024, PIN(22) + layer * 1024, p.out + O_YP, nullptr);
            else            ln_phase(tid, WSP(bf16_t, WS_T), PIN(21) + layer * 1024, PIN(22) + layer * 1024, nullptr, WSP(bf16_t, WS_XB));
        }
    }
}
constexpr int N_PHASES = 1 + 4 * 8;

extern "C" void kernel_launch(void* const* d_in, const int* in_sizes, int n_in, void* d_out, int out_size, void* d_ws, size_t ws_size, hipStream_t stream) {
    static int grid = 0;
    if (grid == 0) {
        if (n_in != 23 || (size_t)out_size != O_END || ws_size < WS_END) { fprintf(stderr, "kernel_launch: unexpected shapes n_in %d out %d ws %zu (need %zu)\n", n_in, out_size, ws_size, (size_t)WS_END); grid = -1; return; }
        int dev = 0, cus = 0, per_cu = 0;
        hipGetDevice(&dev);
        hipDeviceGetAttribute(&cus, hipDeviceAttributeMultiprocessorCount, dev);
        hipFuncSetAttribute((const void*)fwd_megakernel, hipFuncAttributeMaxDynamicSharedMemorySize, LDS_BYTES);
        hipOccupancyMaxActiveBlocksPerMultiprocessor(&per_cu, (const void*)fwd_megakernel, NTHR, LDS_BYTES);
        (void)hipGetLastError();
        grid = cus * (per_cu >= 1 ? 1 : 1);
        fprintf(stderr, "kernel_launch: cus %d per_cu %d grid %d\n", cus, per_cu, grid);
    }
    if (grid < 0) return;
    if (hipMemsetAsync((char*)d_ws + WS_BAR, 0, 16384, stream) != hipSuccess) { fprintf(stderr, "kernel_launch: memset of the barrier words failed\n"); return; }
    Params p{};
    for (int i = 0; i < 23; ++i) p.in[i] = (const float*)d_in[i];
    p.out = (float*)d_out; p.ws = (unsigned char*)d_ws;
    int ph_lo = 0, ph_hi = N_PHASES, use_sync = 1;
    void* args[] = {&p, &ph_lo, &ph_hi, &use_sync};
    hipError_t e = hipLaunchCooperativeKernel((const void*)fwd_megakernel, dim3(grid), dim3(NTHR), args, LDS_BYTES, stream);
    if (e != hipSuccess) fprintf(stderr, "cooperative launch failed: %s (grid %d)\n", hipGetErrorString(e), grid);
}
```
